# Optimizing an MI355X kernel written in HIP

```python
import math
import jax, jax.numpy as jnp
from jax import lax
import numpy as np

D_MODEL = 1024
BATCH = 8
SEQ = 2048
DEPTH = 2

D_FF = 2816
RMS_EPS = 1e-6
LN_EPS = 1e-5
Q_BLOCK = 128
N_BRANCH = 3
DIFF_HEADS = 4
DIFF_HEAD_DIM = 64
DIFF_V_DIM = 2 * DIFF_HEAD_DIM
DIFF_QK_WIDTH = DIFF_HEADS * 2 * DIFF_HEAD_DIM
DIFF_V_WIDTH = DIFF_HEADS * DIFF_V_DIM
FOX_HEADS = 8
FOX_HEAD_DIM = 64
FOX_WIDTH = FOX_HEADS * FOX_HEAD_DIM
MLSTM_HEADS = 4
MLSTM_HEAD_DIM = 128
MLSTM_WIDTH = MLSTM_HEADS * MLSTM_HEAD_DIM
MLSTM_CONV = 4
MLSTM_CHUNK = 128
SPLIT_SIZES = (DIFF_QK_WIDTH, DIFF_QK_WIDTH, DIFF_V_WIDTH,
               FOX_WIDTH, FOX_WIDTH, FOX_WIDTH, FOX_HEADS,
               MLSTM_WIDTH, MLSTM_WIDTH,
               N_BRANCH * D_MODEL)
N_IN = sum(SPLIT_SIZES)

kernel_name = "hybrid_diffattn_fox_mlstm_macaron"


def rms_norm(x, w):
    x32 = x.astype(jnp.float32)
    y = x32 * lax.rsqrt(jnp.mean(x32 * x32, axis=-1, keepdims=True) + RMS_EPS)
    return (y * w.astype(jnp.float32)).astype(x.dtype)


def swiglu(x, w_gate, w_up, w_down):
    return (jax.nn.silu(x @ w_gate) * (x @ w_up)) @ w_down


def split_columns(p):
    offsets = []
    acc = 0
    for s in SPLIT_SIZES[:-1]:
        acc += s
        offsets.append(acc)
    return jnp.split(p, offsets, axis=-1)


def alibi_slopes(n):
    return np.array([2.0 ** (-8.0 * (h + 1) / n) for h in range(n)], dtype=np.float32)


def causal_block_attention(q, k, v, bias_fn):
    B, H, S, dk = q.shape
    dv = v.shape[-1]
    nb = S // Q_BLOCK
    qb = q.reshape(B, H, nb, Q_BLOCK, dk).transpose(2, 0, 1, 3, 4)
    k_pos = jnp.arange(S)
    scale = dk ** -0.5

    def one_block(args):
        blk, q_i = args
        q_pos = blk * Q_BLOCK + jnp.arange(Q_BLOCK)
        logits = jnp.einsum('bhtd,bhsd->bhts', q_i, k).astype(jnp.float32) * scale
        logits = logits + bias_fn(blk, q_pos, k_pos)
        logits = jnp.where(k_pos[None, :] <= q_pos[:, None], logits, -jnp.inf)
        p = jax.nn.softmax(logits, axis=-1).astype(v.dtype)
        return jnp.einsum('bhts,bhse->bhte', p, v)

    out = lax.map(one_block, (jnp.arange(nb), qb))
    return out.transpose(1, 2, 0, 3, 4).reshape(B, H, S, dv)


def causal_depthwise_conv(x, w, b):
    C = x.shape[-1]
    y = lax.conv_general_dilated(x, w[:, None, :].astype(x.dtype), window_strides=(1,),
                                 padding=[(w.shape[0] - 1, 0)],
                                 dimension_numbers=('NWC', 'WIO', 'NWC'),
                                 feature_group_count=C)
    return y + b


def mlstm_chunkwise(q, k, v, log_i, log_f):
    B, H, S, dk = q.shape
    dv = v.shape[-1]
    L = MLSTM_CHUNK
    nc = S // L
    f32 = jnp.float32

    def chunks(a):
        return a.astype(f32).reshape(B, H, nc, L, a.shape[-1]).transpose(2, 0, 1, 3, 4)

    def gchunks(a):
        return a.astype(f32).reshape(B, H, nc, L).transpose(2, 0, 1, 3)

    qc, kc, vc = chunks(q), chunks(k * dk ** -0.5), chunks(v)
    lic, lfc = gchunks(log_i), gchunks(log_f)
    causal = jnp.tril(jnp.ones((L, L), dtype=bool))

    def step(carry, xs):
        C, n, m = carry
        q_c, k_c, v_c, li, lf = xs
        b = jnp.cumsum(lf, axis=-1)
        b_last = b[..., -1]
        D = b[..., :, None] - b[..., None, :] + li[..., None, :]
        D = jnp.where(causal, D, -jnp.inf)
        inter = b + m[..., None]
        m_t = jnp.maximum(inter, jnp.max(D, axis=-1))
        w_intra = jnp.exp(D - m_t[..., None])
        w_inter = jnp.exp(inter - m_t)
        s = jnp.einsum('bhtd,bhsd->bhts', q_c, k_c) * w_intra
        num = w_inter[..., None] * jnp.einsum('bhtd,bhde->bhte', q_c, C) + jnp.einsum('bhts,bhse->bhte', s, v_c)
        den = w_inter * jnp.einsum('bhtd,bhd->bht', q_c, n) + jnp.sum(s, axis=-1)
        h = num / jnp.maximum(jnp.abs(den), jnp.exp(-m_t))[..., None]
        g = b_last[..., None] - b + li
        m_new = jnp.maximum(b_last + m, jnp.max(g, axis=-1))
        wk = jnp.exp(g - m_new[..., None])
        dec = jnp.exp(b_last + m - m_new)
        C_new = dec[..., None, None] * C + jnp.einsum('bhs,bhsd,bhse->bhde', wk, k_c, v_c)
        n_new = dec[..., None] * n + jnp.einsum('bhs,bhsd->bhd', wk, k_c)
        return (C_new, n_new, m_new), h

    init = (jnp.zeros((B, H, dk, dv), f32), jnp.zeros((B, H, dk), f32), jnp.zeros((B, H), f32))
    _, hs = lax.scan(step, init, (qc, kc, vc, lic, lfc))
    return hs.transpose(1, 2, 0, 3, 4).reshape(B, H, S, dv)


def hybrid_mixer(h, layer_idx, w_in, gate_bias,
                 diff_lq1, diff_lk1, diff_lq2, diff_lk2, diff_subln,
                 fox_b_f,
                 mlstm_conv_w, mlstm_conv_b, mlstm_wq, mlstm_wk, mlstm_wv, mlstm_w_if, mlstm_b_if,
                 mlstm_norm, mlstm_skip,
                 w_branch_diff, w_branch_fox, w_branch_mlstm, w_out):
    B, S, _ = h.shape
    f32 = jnp.float32
    proj = h @ w_in
    d_q, d_k, d_v, f_q, f_k, f_v, f_f, m_x, m_z, g_pre = split_columns(proj)

    dq = d_q.reshape(B, S, DIFF_HEADS, 2, DIFF_HEAD_DIM)
    dk_ = d_k.reshape(B, S, DIFF_HEADS, 2, DIFF_HEAD_DIM)
    q1, q2 = dq[..., 0, :].transpose(0, 2, 1, 3), dq[..., 1, :].transpose(0, 2, 1, 3)
    k1, k2 = dk_[..., 0, :].transpose(0, 2, 1, 3), dk_[..., 1, :].transpose(0, 2, 1, 3)
    dv = d_v.reshape(B, S, DIFF_HEADS, DIFF_V_DIM).transpose(0, 2, 1, 3)
    slopes = jnp.asarray(alibi_slopes(DIFF_HEADS))

    def alibi_bias(blk, q_pos, k_pos):
        dist = (q_pos[:, None] - k_pos[None, :]).astype(f32)
        return -(slopes[:, None, None] * dist[None])[None]

    a1 = causal_block_attention(q1, k1, dv, alibi_bias).astype(f32)
    a2 = causal_block_attention(q2, k2, dv, alibi_bias).astype(f32)
    lam_init = 0.8 - 0.6 * math.exp(-0.3 * layer_idx)
    lam = (jnp.exp(jnp.sum(diff_lq1.astype(f32) * diff_lk1.astype(f32)))
           - jnp.exp(jnp.sum(diff_lq2.astype(f32) * diff_lk2.astype(f32))) + lam_init)
    o_a = rms_norm(a1 - lam * a2, diff_subln) * (1.0 - lam_init)
    o_diff = o_a.transpose(0, 2, 1, 3).reshape(B, S, DIFF_V_WIDTH).astype(h.dtype)

    fq = f_q.reshape(B, S, FOX_HEADS, FOX_HEAD_DIM).transpose(0, 2, 1, 3)
    fk = f_k.reshape(B, S, FOX_HEADS, FOX_HEAD_DIM).transpose(0, 2, 1, 3)
    fv = f_v.reshape(B, S, FOX_HEADS, FOX_HEAD_DIM).transpose(0, 2, 1, 3)
    log_fg = jax.nn.log_sigmoid(f_f.astype(f32) + fox_b_f.astype(f32))
    F = jnp.cumsum(log_fg, axis=1).transpose(0, 2, 1)

    def fox_bias(blk, q_pos, k_pos):
        F_q = lax.dynamic_slice_in_dim(F, blk * Q_BLOCK, Q_BLOCK, axis=2)
        return F_q[..., :, None] - F[..., None, :]

    o_f = causal_block_attention(fq, fk, fv, fox_bias)
    o_fox = o_f.transpose(0, 2, 1, 3).reshape(B, S, FOX_WIDTH)

    x_c = jax.nn.silu(causal_depthwise_conv(m_x, mlstm_conv_w, mlstm_conv_b))
    xh = x_c.reshape(B, S, MLSTM_HEADS, MLSTM_HEAD_DIM)
    vh = m_x.reshape(B, S, MLSTM_HEADS, MLSTM_HEAD_DIM)
    mq = jnp.einsum('bshd,hde->bshe', xh, mlstm_wq)
    mk = jnp.einsum('bshd,hde->bshe', xh, mlstm_wk)
    mv = jnp.einsum('bshd,hde->bshe', vh, mlstm_wv)
    qkv_flat = jnp.concatenate([mq.reshape(B, S, MLSTM_WIDTH), mk.reshape(B, S, MLSTM_WIDTH),
                                mv.reshape(B, S, MLSTM_WIDTH)], axis=-1)
    if_pre = (qkv_flat @ mlstm_w_if + mlstm_b_if).astype(f32)
    log_i = if_pre[..., :MLSTM_HEADS].transpose(0, 2, 1)
    log_f = jax.nn.log_sigmoid(if_pre[..., MLSTM_HEADS:]).transpose(0, 2, 1)
    hm = mlstm_chunkwise(mq.transpose(0, 2, 1, 3), mk.transpose(0, 2, 1, 3),
                         mv.transpose(0, 2, 1, 3), log_i, log_f)
    mu = jnp.mean(hm, axis=-1, keepdims=True)
    var = jnp.mean(jnp.square(hm - mu), axis=-1, keepdims=True)
    hm = (hm - mu) * lax.rsqrt(var + LN_EPS)
    hm = hm.transpose(0, 2, 1, 3).reshape(B, S, MLSTM_WIDTH) * mlstm_norm.astype(f32)
    o_mlstm = ((hm.astype(h.dtype) + mlstm_skip * x_c) * jax.nn.silu(m_z))

    gates = jax.nn.sigmoid(g_pre.reshape(B, S, N_BRANCH, D_MODEL) + gate_bias)
    merged = (gates[..., 0, :] * (o_diff @ w_branch_diff)
              + gates[..., 1, :] * (o_fox @ w_branch_fox)
              + gates[..., 2, :] * (o_mlstm @ w_branch_mlstm))
    return merged @ w_out


def setup_inputs(seed: int = 0) -> dict:
    key = jax.random.key(seed)
    ks = iter(jax.random.split(key, 40))
    f32 = jnp.float32

    def w(shape, fan_in):
        return jax.random.normal(next(ks), shape, f32) * (fan_in ** -0.5)

    def gain(shape):
        return 1.0 + 0.02 * jax.random.normal(next(ks), shape, f32)

    def small(shape, s=0.01):
        return s * jax.random.normal(next(ks), shape, f32)

    L = DEPTH
    fox_b = jnp.tile(jnp.linspace(1.0, 4.0, FOX_HEADS, dtype=f32)[None], (L, 1)) + small((L, FOX_HEADS), 0.1)
    b_i = small((L, MLSTM_HEADS), 0.1)
    b_f = jnp.tile(jnp.linspace(3.0, 6.0, MLSTM_HEADS, dtype=f32)[None], (L, 1)) + small((L, MLSTM_HEADS), 0.1)
    return {
        "x": jax.random.normal(next(ks), (BATCH, SEQ, D_MODEL), f32),
        "ffn1_norm": gain((L, D_MODEL)),
        "ffn1_w_gate": w((L, D_MODEL, D_FF), D_MODEL),
        "ffn1_w_up": w((L, D_MODEL, D_FF), D_MODEL),
        "ffn1_w_down": w((L, D_FF, D_MODEL), D_FF),
        "mix_norm": gain((L, D_MODEL)),
        "w_in": w((L, D_MODEL, N_IN), D_MODEL),
        "gate_bias": small((L, N_BRANCH, D_MODEL)),
        "diff_lq1": small((L, DIFF_HEAD_DIM), 0.1),
        "diff_lk1": small((L, DIFF_HEAD_DIM), 0.1),
        "diff_lq2": small((L, DIFF_HEAD_DIM), 0.1),
        "diff_lk2": small((L, DIFF_HEAD_DIM), 0.1),
        "diff_subln": gain((L, DIFF_V_DIM)),
        "fox_b_f": fox_b,
        "mlstm_conv_w": w((L, MLSTM_CONV, MLSTM_WIDTH), MLSTM_CONV),
        "mlstm_conv_b": small((L, MLSTM_WIDTH)),
        "mlstm_wq": w((L, MLSTM_HEADS, MLSTM_HEAD_DIM, MLSTM_HEAD_DIM), MLSTM_HEAD_DIM),
        "mlstm_wk": w((L, MLSTM_HEADS, MLSTM_HEAD_DIM, MLSTM_HEAD_DIM), MLSTM_HEAD_DIM),
        "mlstm_wv": w((L, MLSTM_HEADS, MLSTM_HEAD_DIM, MLSTM_HEAD_DIM), MLSTM_HEAD_DIM),
        "mlstm_w_if": w((L, 3 * MLSTM_WIDTH, 2 * MLSTM_HEADS), 3 * MLSTM_WIDTH),
        "mlstm_b_if": jnp.concatenate([b_i, b_f], axis=-1),
        "mlstm_norm": gain((L, MLSTM_WIDTH)),
        "mlstm_skip": gain((L, MLSTM_WIDTH)),
        "w_branch_diff": w((L, DIFF_V_WIDTH, D_MODEL), DIFF_V_WIDTH),
        "w_branch_fox": w((L, FOX_WIDTH, D_MODEL), FOX_WIDTH),
        "w_branch_mlstm": w((L, MLSTM_WIDTH, D_MODEL), MLSTM_WIDTH),
        "w_out": w((L, D_MODEL, D_MODEL), D_MODEL),
        "ffn2_norm": gain((L, D_MODEL)),
        "ffn2_w_gate": w((L, D_MODEL, D_FF), D_MODEL),
        "ffn2_w_up": w((L, D_MODEL, D_FF), D_MODEL),
        "ffn2_w_down": w((L, D_FF, D_MODEL), D_FF),
        "final_norm": gain((D_MODEL,)),
    }


def reference(x, ffn1_norm, ffn1_w_gate, ffn1_w_up, ffn1_w_down,
              mix_norm, w_in, gate_bias,
              diff_lq1, diff_lk1, diff_lq2, diff_lk2, diff_subln,
              fox_b_f,
              mlstm_conv_w, mlstm_conv_b, mlstm_wq, mlstm_wk, mlstm_wv, mlstm_w_if, mlstm_b_if,
              mlstm_norm, mlstm_skip,
              w_branch_diff, w_branch_fox, w_branch_mlstm, w_out,
              ffn2_norm, ffn2_w_gate, ffn2_w_up, ffn2_w_down,
              final_norm):
    for l in range(DEPTH):
        x = x + 0.5 * swiglu(rms_norm(x, ffn1_norm[l]), ffn1_w_gate[l], ffn1_w_up[l], ffn1_w_down[l])
        x = x + hybrid_mixer(rms_norm(x, mix_norm[l]), l, w_in[l], gate_bias[l],
                             diff_lq1[l], diff_lk1[l], diff_lq2[l], diff_lk2[l], diff_subln[l],
                             fox_b_f[l],
                             mlstm_conv_w[l], mlstm_conv_b[l], mlstm_wq[l], mlstm_wk[l], mlstm_wv[l],
                             mlstm_w_if[l], mlstm_b_if[l], mlstm_norm[l], mlstm_skip[l],
                             w_branch_diff[l], w_branch_fox[l], w_branch_mlstm[l], w_out[l])
        x = x + 0.5 * swiglu(rms_norm(x, ffn2_norm[l]), ffn2_w_gate[l], ffn2_w_up[l], ffn2_w_down[l])
    return rms_norm(x, final_norm)
```

```cpp
#include <hip/hip_runtime.h>
#include <hip/hip_cooperative_groups.h>
#include <cstdio>
#include <cstdint>
#include <cmath>
namespace cg = cooperative_groups;

#ifndef MK_COOP
#define MK_COOP 0
#endif
#ifndef MK_N_LAUNCHES
#define MK_N_LAUNCHES 1
#endif

constexpr size_t SLOT_STRIDE_E = (size_t)16384 * 512 + 12288;

namespace pg8 {
#define PG8_LAS __attribute__((address_space(3)))
typedef unsigned short bf16_t;
typedef short bf16x8 __attribute__((ext_vector_type(8)));
typedef float f32x4 __attribute__((ext_vector_type(4)));
typedef unsigned u32x4 __attribute__((ext_vector_type(4)));
typedef unsigned u32x2 __attribute__((ext_vector_type(2)));
constexpr int BM = 256, BK = 64, HALF = 128, HTB = HALF * BK * 2  , STAGE_BYTES = 8 * HTB, NXCD = 8, WGM = 8;

__host__ __device__ __forceinline__ int lds_byte(int r, int c) { const int st = (r >> 4) * 2 + (c >> 5), rr = r & 15, cc = c & 31, ob = rr * 64 + cc * 2; return st * 1024 + (ob ^ (((ob >> 9) & 1) << 5)); }
__host__ __device__ __forceinline__ void stage_rc(int b, int& R, int& C) { const int st = b / 1024, sb = b % 1024, swz = sb ^ (((sb >> 9) & 1) << 5); R = (st >> 1) * 16 + swz / 64; C = (st & 1) * 32 + (swz % 64) / 2; }
__host__ __device__ __forceinline__ int perm32(int rho) { const int n = rho >> 4, i = rho & 15; return 8 * (i >> 2) + 4 * n + (i & 3); }

struct Unit { int pm, pn, z, ord; };
struct Gemm { const bf16_t* A; const bf16_t* B; long azs, bzs; int K;
    __device__ __forceinline__ const char* a(int z) const { return (const char*)(A + (long)z * azs); }
    __device__ __forceinline__ const char* b(int z) const { return (const char*)(B + (long)z * bzs); } };

struct StaticOrder {
    int nM, nN, nwg, G, c;
    __host__ __device__ void init(int M, int N, int G_, int c_) { nM = M / BM; nN = N / BM; nwg = nM * nN; G = G_; c = c_; }
    __host__ __device__ bool next(int i, Unit& u) const {
        const long L = (long)i * G + c; if (L >= nwg) return false;
        int wgid = (int)L; { const int q = nwg / NXCD, r = nwg % NXCD, xcd = wgid % NXCD, off = wgid / NXCD; wgid = (xcd < r ? xcd * (q + 1) : r * (q + 1) + (xcd - r) * q) + off; }
        const int nig = WGM * nN, gid = wgid / nig, fm = gid * WGM, gsz = (nM - fm) < WGM ? (nM - fm) : WGM;
        u.pm = fm + ((wgid % nig) % gsz); u.pn = (wgid % nig) / gsz; u.z = 0; u.ord = i; return true;
    }
    __device__ __forceinline__ void a_ready(const Unit&) const {}
    __device__ __forceinline__ void done(const Unit&) const {}
};

typedef float f32x2_t __attribute__((ext_vector_type(2))); typedef __bf16 bf16x2_t __attribute__((ext_vector_type(2)));
__device__ __forceinline__ unsigned pkbf(float lo, float hi) { f32x2_t v = {lo, hi}; bf16x2_t b = __builtin_convertvector(v, bf16x2_t); return __builtin_bit_cast(unsigned, b); }
__device__ __forceinline__ float bflo(unsigned w) { return __builtin_bit_cast(float, w << 16); }
__device__ __forceinline__ float bfhi(unsigned w) { return __builtin_bit_cast(float, w & 0xffff0000u); }
constexpr float RMS_EPS_F = 1e-6f;
__device__ __forceinline__ float row_rstd(const float* RS, int row) {
    const f32x4* p = (const f32x4*)(RS + (size_t)row * 16);
    const f32x4 a = p[0], b = p[1], c = p[2], d = p[3];
    const float s = (((a[0] + a[1]) + (a[2] + a[3])) + ((b[0] + b[1]) + (b[2] + b[3]))) + (((c[0] + c[1]) + (c[2] + c[3])) + ((d[0] + d[1]) + (d[2] + d[3])));
    return 1.0f / sqrtf(s * (1.0f / 1024.0f) + RMS_EPS_F);
}
__device__ __forceinline__ void rows_rstd8(const float* RS, int row0, int fq, float (&rs)[8]) {
    f32x4 q[8];
#pragma unroll
    for (int i = 0; i < 8; ++i) q[i] = *(const f32x4*)(RS + (size_t)(row0 + (i >> 2) * HALF + (i & 3) * 16) * 16 + 4 * fq);
#pragma unroll
    for (int i = 0; i < 8; ++i) { float s = (q[i][0] + q[i][1]) + (q[i][2] + q[i][3]); s += __shfl_xor(s, 16); s += __shfl_xor(s, 32); rs[i] = 1.0f / sqrtf(s * (1.0f / 1024.0f) + RMS_EPS_F); }
}
typedef PG8_LAS float* lds_fp;
template <class Sched> __device__ __forceinline__ void fill_rstd_table(const Sched& S, const float* RS, lds_fp tab, int tid) {
    f32x4 q[3][4]; bool ok[3];
#pragma unroll
    for (int k = 0; k < 3; ++k) { Unit v; ok[k] = S.next(2 * k + (tid >> 8), v); const int row = ok[k] ? v.pm * BM + (tid & 255) : 0; const f32x4* p = (const f32x4*)(RS + (size_t)row * 16);
#pragma unroll
        for (int j = 0; j < 4; ++j) q[k][j] = p[j]; }
#pragma unroll
    for (int k = 0; k < 3; ++k) { const f32x4 a = q[k][0], b = q[k][1], c = q[k][2], d = q[k][3];
        const float s = (((a[0] + a[1]) + (a[2] + a[3])) + ((b[0] + b[1]) + (b[2] + b[3]))) + (((c[0] + c[1]) + (c[2] + c[3])) + ((d[0] + d[1]) + (d[2] + d[3])));
        if (ok[k]) tab[(2 * k + (tid >> 8)) * 256 + (tid & 255)] = 1.0f / sqrtf(s * (1.0f / 1024.0f) + RMS_EPS_F); }
    __syncthreads();
}
__device__ __forceinline__ void rows_rstd8_lds(lds_fp tab, int ord, int wr, int fr, float (&rs)[8]) {
#pragma unroll
    for (int i = 0; i < 8; ++i) rs[i] = tab[ord * 256 + (i >> 2) * HALF + wr * 64 + (i & 3) * 16 + fr];
}
__device__ __forceinline__ void prog_wait(unsigned* xsub, unsigned need, int lane) {
    if (xsub) { unsigned sp = 0u;
        for (;;) { const unsigned v = (lane < 8) ? __hip_atomic_load(xsub + 64 * lane, __ATOMIC_RELAXED, __HIP_MEMORY_SCOPE_AGENT) : need;
            if (__all(v >= need)) break; __builtin_amdgcn_s_sleep(1); if (++sp > (1u << 20)) break; } } }
__device__ __forceinline__ float sigmoidf_(float x) { return __builtin_amdgcn_rcpf(1.0f + __expf(-x)); }

struct EpiSwiGLU {
    static constexpr bool PERM = true, AFTER_DRAIN = false, KEEP_ACC = false;
    bf16_t* H; lds_fp tab; unsigned* xsub; unsigned need;
    __device__ __forceinline__ void pre_store(int lane) const { prog_wait(xsub, need, lane); }
    __device__ __forceinline__ void operator()(const f32x4 (&acc)[2][2][4][2], const Unit& u, int wr, int wc, int fr, int fq) const {
        const int row0 = u.pm * BM + wr * 64 + fr; const int col0 = u.pn * 128 + wc * 32 + 8 * fq;
        float rs8[8]; rows_rstd8_lds(tab, u.ord, wr, fr, rs8);
#pragma unroll
        for (int ai = 0; ai < 2; ++ai)
#pragma unroll
            for (int m = 0; m < 4; ++m) { const int row = row0 + ai * HALF + m * 16; const float rs = rs8[ai * 4 + m];
                const float c = -1.4426950408889634f * rs, rs2 = rs * rs;
                float hv[8];
#pragma unroll
                for (int n = 0; n < 2; ++n) { const f32x4 g = acc[ai][0][m][n], up = acc[ai][1][m][n]; const f32x4 t = g * c; f32x4 r;
#pragma unroll
                    for (int i = 0; i < 4; ++i) r[i] = __builtin_amdgcn_exp2f(t[i]);
                    r = r + 1.0f;
#pragma unroll
                    for (int i = 0; i < 4; ++i) r[i] = __builtin_amdgcn_rcpf(r[i]);
                    const f32x4 h = (g * up) * (r * rs2);
#pragma unroll
                    for (int i = 0; i < 4; ++i) hv[4 * n + i] = h[i]; }
                u32x4 w; w.x = pkbf(hv[0], hv[1]); w.y = pkbf(hv[2], hv[3]); w.z = pkbf(hv[4], hv[5]); w.w = pkbf(hv[6], hv[7]);
                __builtin_nontemporal_store(w, (u32x4*)(H + (size_t)row * 2816 + col0)); }
    }
};
struct EpiResid {
    static constexpr bool PERM = true, AFTER_DRAIN = false, KEEP_ACC = false;
    const bf16_t* base; bf16_t* XB; float* RS; float scale;
    __device__ __forceinline__ void pre_store(int) const {}
    __device__ __forceinline__ void operator()(const f32x4 (&acc)[2][2][4][2], const Unit& u, int wr, int wc, int fr, int fq) const {
        const int row0 = u.pm * BM + wr * 64 + fr; const int col0 = u.pn * BM + wc * 32 + 8 * fq;
        u32x4 nb[2];
#pragma unroll
        for (int bj = 0; bj < 2; ++bj) nb[bj] = *(const u32x4*)(base + (size_t)row0 * 1024 + col0 + bj * HALF);
#pragma unroll
        for (int i = 0; i < 8; ++i) { const int ai = i >> 2, m = i & 3; const int row = row0 + ai * HALF + m * 16; const size_t off = (size_t)row * 1024 + col0; float s = 0.f;
            u32x4 cb[2];
#pragma unroll
            for (int bj = 0; bj < 2; ++bj) cb[bj] = nb[bj];
            if (i < 7) { const int rown = row0 + ((i + 1) >> 2) * HALF + ((i + 1) & 3) * 16;
#pragma unroll
                for (int bj = 0; bj < 2; ++bj) nb[bj] = *(const u32x4*)(base + (size_t)rown * 1024 + col0 + bj * HALF); }
#pragma unroll
            for (int bj = 0; bj < 2; ++bj) { const u32x4 bw = cb[bj]; const f32x4 a0 = acc[ai][bj][m][0] * scale, a1 = acc[ai][bj][m][1] * scale;
                u32x4 w; w.x = pkbf(bflo(bw.x) + a0[0], bfhi(bw.x) + a0[1]); w.y = pkbf(bflo(bw.y) + a0[2], bfhi(bw.y) + a0[3]); w.z = pkbf(bflo(bw.z) + a1[0], bfhi(bw.z) + a1[1]); w.w = pkbf(bflo(bw.w) + a1[2], bfhi(bw.w) + a1[3]);
                *(u32x4*)(XB + off + bj * HALF) = w;
                const float x0 = bflo(w.x), x1 = bfhi(w.x), x2 = bflo(w.y), x3 = bfhi(w.y), x4 = bflo(w.z), x5 = bfhi(w.z), x6 = bflo(w.w), x7 = bfhi(w.w);
                s += ((x0 * x0 + x1 * x1) + (x2 * x2 + x3 * x3)) + ((x4 * x4 + x5 * x5) + (x6 * x6 + x7 * x7)); }
            s += __shfl_xor(s, 16); s += __shfl_xor(s, 32);
            if (fq == 0) RS[(size_t)row * 16 + u.pn * 4 + wc] = s;
            asm volatile("" ::: "memory"); }
    }
};
struct EpiProj {
    static constexpr bool PERM = true, AFTER_DRAIN = false, KEEP_ACC = false;
    bf16_t* SLOT; lds_fp tab; float qscale; unsigned* xsub; unsigned need;
    __device__ __forceinline__ void pre_store(int lane) const { prog_wait(xsub, need, lane); }
    __device__ __forceinline__ void operator()(const f32x4 (&acc)[2][2][4][2], const Unit& u, int wr, int wc, int fr, int fq) const {
        const int grp = u.pn >> 1; const int slot = (int)((0x43761520u >> (4 * grp)) & 15u); const float sc = (grp == 0 || grp == 3) ? qscale : 1.0f;
        bf16_t* dst = SLOT + (size_t)slot * SLOT_STRIDE_E;
        const int row0 = u.pm * BM + wr * 64 + fr; const int col0 = (u.pn & 1) * 256 + wc * 32 + 8 * fq;
        float rs8[8]; rows_rstd8_lds(tab, u.ord, wr, fr, rs8);
#pragma unroll
        for (int ai = 0; ai < 2; ++ai)
#pragma unroll
            for (int m = 0; m < 4; ++m) { const int row = row0 + ai * HALF + m * 16; const float rs = rs8[ai * 4 + m] * sc;
#pragma unroll
                for (int bj = 0; bj < 2; ++bj) { const f32x4 v0 = acc[ai][bj][m][0] * rs, v1 = acc[ai][bj][m][1] * rs;
                    u32x4 w; w.x = pkbf(v0[0], v0[1]); w.y = pkbf(v0[2], v0[3]); w.z = pkbf(v1[0], v1[1]); w.w = pkbf(v1[2], v1[3]);
                    __builtin_nontemporal_store(w, (u32x4*)(dst + (size_t)row * 512 + col0 + bj * HALF)); } }
    }
};
struct EpiGate {
    static constexpr bool PERM = true, AFTER_DRAIN = false, KEEP_ACC = false;
    unsigned* xsub; unsigned need;
    __device__ __forceinline__ void pre_store(int lane) const { prog_wait(xsub, need, lane); }
    bf16_t* G; lds_fp tab; lds_fp gb_lds;
    __device__ __forceinline__ void operator()(const f32x4 (&acc)[2][2][4][2], const Unit& u, int wr, int wc, int fr, int fq) const {
        const int gi = u.z; unsigned char* dst = (unsigned char*)(G + (size_t)gi * SLOT_STRIDE_E);
        const int row0 = u.pm * BM + wr * 64 + fr; const int col0 = u.pn * 256 + wc * 32 + 8 * fq; const lds_fp gb = gb_lds + gi * 1024 + col0;
        f32x4 bv[2][2];
#pragma unroll
        for (int bj = 0; bj < 2; ++bj)
#pragma unroll
            for (int n = 0; n < 2; ++n) bv[bj][n] = *(const PG8_LAS f32x4*)(gb + bj * HALF + 4 * n) * (-1.4426950408889634f);
        float rs8[8]; rows_rstd8_lds(tab, u.ord, wr, fr, rs8);
#pragma unroll
        for (int ai = 0; ai < 2; ++ai)
#pragma unroll
            for (int m = 0; m < 4; ++m) { const int row = row0 + ai * HALF + m * 16; const float c = -1.4426950408889634f * rs8[ai * 4 + m];
#pragma unroll
                for (int bj = 0; bj < 2; ++bj) { f32x4 v0 = acc[ai][bj][m][0] * c + bv[bj][0], v1 = acc[ai][bj][m][1] * c + bv[bj][1];
#pragma unroll
                    for (int i = 0; i < 4; ++i) { v0[i] = __builtin_amdgcn_exp2f(v0[i]); v1[i] = __builtin_amdgcn_exp2f(v1[i]); }
                    v0 = v0 + 1.0f; v1 = v1 + 1.0f;
#pragma unroll
                    for (int i = 0; i < 4; ++i) { v0[i] = __builtin_amdgcn_rsqf(v0[i]); v1[i] = __builtin_amdgcn_rsqf(v1[i]); }
                    v0 = v0 * 255.0f; v1 = v1 * 255.0f; u32x2 w; w.x = 0u; w.y = 0u;
#pragma unroll
                    for (int i = 0; i < 4; ++i) { v0[i] = __builtin_fmaxf(v0[i], 1.0f); v1[i] = __builtin_fmaxf(v1[i], 1.0f); }
#pragma unroll
                    for (int i = 0; i < 4; ++i) { w.x = __builtin_amdgcn_cvt_pk_u8_f32(v0[i], i, w.x); w.y = __builtin_amdgcn_cvt_pk_u8_f32(v1[i], i, w.y); }
                    __builtin_nontemporal_store(w, (u32x2*)(dst + (size_t)row * 1024 + col0 + bj * HALF)); } }
    }
};
struct EpiBranch {
    static constexpr bool PERM = true, AFTER_DRAIN = false, KEEP_ACC = true;
    const bf16_t* Gb; bf16_t* MG;
    __device__ __forceinline__ void pre_store(int) const {}
    __device__ __forceinline__ void operator()(const f32x4 (&acc_)[2][2][4][2], const Unit& u, int wr, int wc, int fr, int fq) const {
        f32x4 (&acc)[2][2][4][2] = const_cast<f32x4 (&)[2][2][4][2]>(acc_);
        const unsigned char* G = (const unsigned char*)(Gb + (size_t)u.z * SLOT_STRIDE_E);
        const unsigned char* Gn = G + SLOT_STRIDE_E * 2;
        const int row0 = u.pm * BM + wr * 64 + fr; const int col0 = u.pn * BM + wc * 32 + 8 * fq; const bool fin = (u.z == 2);
        u32x2 ng[2], nn[2];
#pragma unroll
        for (int bj = 0; bj < 2; ++bj) { const size_t off = (size_t)row0 * 1024 + col0 + bj * HALF; ng[bj] = *(const u32x2*)(G + off); if (!fin) nn[bj] = *(const u32x2*)(Gn + off); else nn[bj] = (u32x2){0x01010101u, 0x01010101u}; }
#pragma unroll
        for (int i = 0; i < 8; ++i) { const int ai = i >> 2, m = i & 3; const int row = row0 + ai * HALF + m * 16;
            u32x2 cg[2], cn[2];
#pragma unroll
            for (int bj = 0; bj < 2; ++bj) { cg[bj] = ng[bj]; cn[bj] = nn[bj]; }
            if (i < 7) { const int rown = row0 + ((i + 1) >> 2) * HALF + ((i + 1) & 3) * 16;
#pragma unroll
                for (int bj = 0; bj < 2; ++bj) { const size_t off = (size_t)rown * 1024 + col0 + bj * HALF; ng[bj] = *(const u32x2*)(G + off); if (!fin) nn[bj] = *(const u32x2*)(Gn + off); } }
#pragma unroll
            for (int bj = 0; bj < 2; ++bj) { const u32x2 gw = cg[bj], gn = cn[bj];
                float gz[8] = {(float)(gw.x & 255u), (float)((gw.x >> 8) & 255u), (float)((gw.x >> 16) & 255u), (float)(gw.x >> 24), (float)(gw.y & 255u), (float)((gw.y >> 8) & 255u), (float)((gw.y >> 16) & 255u), (float)(gw.y >> 24)};
                float gd[8] = {(float)(gn.x & 255u), (float)((gn.x >> 8) & 255u), (float)((gn.x >> 16) & 255u), (float)(gn.x >> 24), (float)(gn.y & 255u), (float)((gn.y >> 8) & 255u), (float)((gn.y >> 16) & 255u), (float)(gn.y >> 24)};
                f32x4 r0, r1;
#pragma unroll
                for (int k = 0; k < 4; ++k) { r0[k] = fin ? gz[k] * (1.0f / 255.0f) : gz[k] * __builtin_amdgcn_rcpf(gd[k]); r1[k] = fin ? gz[4 + k] * (1.0f / 255.0f) : gz[4 + k] * __builtin_amdgcn_rcpf(gd[4 + k]); }
                r0 = r0 * r0; r1 = r1 * r1;
                const f32x4 a0 = acc[ai][bj][m][0] * r0, a1 = acc[ai][bj][m][1] * r1;
                acc[ai][bj][m][0] = a0; acc[ai][bj][m][1] = a1;
                if (fin) { u32x4 w; w.x = pkbf(a0[0], a0[1]); w.y = pkbf(a0[2], a0[3]); w.z = pkbf(a1[0], a1[1]); w.w = pkbf(a1[2], a1[3]);
                    *(u32x4*)(MG + (size_t)row * 1024 + col0 + bj * HALF) = w; } }
            asm volatile("" ::: "memory"); }
    }
};
struct BranchOrder {
    StaticOrder so;
    __device__ void init(int M, int N, int G_, int c_) { so.init(M, N, G_, c_); }
    __device__ bool next(int i, Unit& u) const { const int t = i / 3; if (!so.next(t, u)) return false; u.z = i - 3 * t; return true; }
    __device__ __forceinline__ void a_ready(const Unit&) const {}
    __device__ __forceinline__ void done(const Unit&) const {}
};
template <class Epi, class Sched, bool ALIGN_EPI = false, bool SP2 = false>
__device__ __forceinline__ void gemm_phase(PG8_LAS unsigned char* lds, const Gemm g, const Sched& S, const Epi& E) {
    int tid_ = threadIdx.x; asm volatile("" : "+v"(tid_));
    const int tid = tid_, wid = __builtin_amdgcn_readfirstlane(tid >> 6), lane = tid & 63, wr = wid >> 2, wc = wid & 3, fr = lane & 15, fq = lane >> 4;
    const int K = g.K, nt = K / BK;
    unsigned voffA[2], voffB[2];
#pragma unroll
    for (int i = 0; i < 2; ++i) { int R, C; stage_rc(tid * 16 + i * 8192, R, C); const int Rb = Epi::PERM ? ((R & ~31) + perm32(R & 31)) : R;
        voffA[i] = (unsigned)(R * K + C) * 2u; voffB[i] = (unsigned)(Rb * K + C) * 2u; }
    const size_t kstep = (size_t)(BK * 2);
    const size_t hstep = (size_t)HALF * K * 2;
    const size_t tstep = 2 * hstep;
    const unsigned ldsw = (unsigned)wid * 1024u;
    const int aoff = lds_byte(wr * 64 + fr, fq * 8), boff = lds_byte(wc * 32 + fr, fq * 8);
#define PG8_SA(b, h) (((b) * 2 + (h)) * HTB)
#define PG8_SB(b, h) ((4 + (b) * 2 + (h)) * HTB)
#define PG8_STAGE(bufoff, gbase, voff) do { _Pragma("unroll") for (int _i = 0; _i < 2; ++_i) \
        __builtin_amdgcn_global_load_lds((const unsigned*)((const char*)(gbase) + (voff)[_i]), (PG8_LAS unsigned*)(lds + (bufoff) + ldsw + _i * 8192), 16, 0, 0); } while (0)
#define PG8_LDA(dst, b, h) do { _Pragma("unroll") for (int m = 0; m < 4; ++m) _Pragma("unroll") for (int k = 0; k < 2; ++k) dst[m][k] = *(const PG8_LAS bf16x8*)(lds + PG8_SA(b, h) + aoff + m * 2048 + k * 1024); } while (0)
#define PG8_LDB(dst, b, h) do { _Pragma("unroll") for (int n = 0; n < 2; ++n) _Pragma("unroll") for (int k = 0; k < 2; ++k) dst[n][k] = *(const PG8_LAS bf16x8*)(lds + PG8_SB(b, h) + boff + n * 2048 + k * 1024); } while (0)
#define PG8_MMA(ai, bj, At, Bt) do { __builtin_amdgcn_s_setprio(1); _Pragma("unroll") for (int m = 0; m < 4; ++m) _Pragma("unroll") for (int n = 0; n < 2; ++n) _Pragma("unroll") for (int k = 0; k < 2; ++k) \
        acc[ai][bj][m][n] = __builtin_amdgcn_mfma_f32_16x16x32_bf16(Bt[n][k], At[m][k], acc[ai][bj][m][n], 0, 0, 0); __builtin_amdgcn_s_setprio(0); } while (0)
#define PG8_WAIT_V(n) asm volatile("s_waitcnt vmcnt(" #n ")" ::: "memory")
#define PG8_WAIT_L(n) asm volatile("s_waitcnt lgkmcnt(" #n ")" ::: "memory")
#define PG8_BAR __builtin_amdgcn_s_barrier()
#define PG8_SCHED __builtin_amdgcn_sched_barrier(0)
    Unit cur, nxt; int ui = 0;
    if (!S.next(0, cur)) return;
    f32x4 acc[2][2][4][2];
#pragma unroll
    for (int a = 0; a < 2; ++a)
#pragma unroll
        for (int b = 0; b < 2; ++b)
#pragma unroll
            for (int m = 0; m < 4; ++m)
#pragma unroll
                for (int n = 0; n < 2; ++n) acc[a][b][m][n] = (f32x4){0.f, 0.f, 0.f, 0.f};
    bf16x8 At[4][2], B0[2][2], B1[2][2];
    const char* cA = g.a(cur.z) + (size_t)cur.pm * tstep; const char* cB = g.b(cur.z) + (size_t)cur.pn * tstep;
    S.a_ready(cur);
    if constexpr (SP2) {
        PG8_STAGE(PG8_SB(0, 0), cB, voffB); PG8_STAGE(PG8_SB(0, 1), cB + hstep, voffB); PG8_STAGE(PG8_SA(0, 0), cA, voffA); PG8_STAGE(PG8_SA(0, 1), cA + hstep, voffA);
        if (wr == 1) PG8_BAR;
        PG8_WAIT_V(2); PG8_BAR;
        PG8_STAGE(PG8_SB(1, 0), cB + kstep, voffB); PG8_STAGE(PG8_SA(1, 0), cA + kstep, voffA); PG8_STAGE(PG8_SB(1, 1), cB + hstep + kstep, voffB);
        PG8_WAIT_V(6); PG8_BAR;
    } else {
        PG8_STAGE(PG8_SB(0, 0), cB, voffB); PG8_STAGE(PG8_SA(0, 0), cA, voffA); PG8_STAGE(PG8_SB(0, 1), cB + hstep, voffB); PG8_STAGE(PG8_SA(0, 1), cA + hstep, voffA);
        if (wr == 1) PG8_BAR;
        PG8_WAIT_V(4); PG8_BAR;
        PG8_STAGE(PG8_SB(1, 0), cB + kstep, voffB); PG8_STAGE(PG8_SA(1, 0), cA + kstep, voffA); PG8_STAGE(PG8_SB(1, 1), cB + hstep + kstep, voffB);
        PG8_WAIT_V(6); PG8_BAR;
    }
    for (;;) {
        const bool has_next = S.next(ui + 1, nxt);
        const char* nA = has_next ? g.a(nxt.z) + (size_t)nxt.pm * tstep : cA; const char* nB = has_next ? g.b(nxt.z) + (size_t)nxt.pn * tstep : cB;
        for (int t = 0; t < nt; t += 2) {
            const bool last = (t == nt - 2);
            const char* a1 = cA + (size_t)(t + 1) * kstep;
            const char* a2 = last ? nA : cA + (size_t)(t + 2) * kstep; const char* b2 = last ? nB : cB + (size_t)(t + 2) * kstep;
            const char* a3 = a2 + kstep; const char* b3 = b2 + kstep;
            if (last && has_next) S.a_ready(nxt);
            if constexpr (SP2) {
            PG8_LDB(B0, 0, 0); PG8_LDB(B1, 0, 1); PG8_SCHED; PG8_LDA(At, 0, 0); PG8_STAGE(PG8_SA(1, 1), a1 + hstep, voffA);
            PG8_WAIT_V(8); PG8_WAIT_L(0); PG8_BAR; PG8_MMA(0, 0, At, B0); PG8_MMA(0, 1, At, B1); PG8_BAR; PG8_SCHED;
            PG8_LDA(At, 0, 1); PG8_STAGE(PG8_SB(0, 0), b2, voffB); PG8_STAGE(PG8_SB(0, 1), b2 + hstep, voffB); PG8_STAGE(PG8_SA(0, 0), a2, voffA);
            PG8_WAIT_V(8); PG8_WAIT_L(0); PG8_BAR; PG8_MMA(1, 0, At, B0); PG8_MMA(1, 1, At, B1); PG8_BAR; PG8_SCHED;
            PG8_LDB(B0, 1, 0); PG8_LDB(B1, 1, 1); PG8_SCHED; PG8_LDA(At, 1, 0); PG8_STAGE(PG8_SA(0, 1), a2 + hstep, voffA);
            PG8_WAIT_V(8); PG8_WAIT_L(0); PG8_BAR; PG8_MMA(0, 0, At, B0); PG8_MMA(0, 1, At, B1); PG8_BAR; PG8_SCHED;
            PG8_LDA(At, 1, 1); PG8_STAGE(PG8_SB(1, 0), b3, voffB); PG8_STAGE(PG8_SB(1, 1), b3 + hstep, voffB); PG8_STAGE(PG8_SA(1, 0), a3, voffA);
            PG8_WAIT_V(8); PG8_WAIT_L(0); PG8_BAR; PG8_MMA(1, 0, At, B0); PG8_MMA(1, 1, At, B1); PG8_BAR; PG8_SCHED;
            } else {
            PG8_LDB(B0, 0, 0); PG8_SCHED; PG8_LDA(At, 0, 0); PG8_STAGE(PG8_SA(1, 1), a1 + hstep, voffA);
            PG8_WAIT_L(8); PG8_BAR; PG8_WAIT_L(0); PG8_MMA(0, 0, At, B0); PG8_BAR; PG8_SCHED;
            PG8_LDB(B1, 0, 1); PG8_STAGE(PG8_SB(0, 0), b2, voffB);
            PG8_BAR; PG8_WAIT_L(0); PG8_MMA(0, 1, At, B1); PG8_BAR;
            PG8_LDA(At, 0, 1); PG8_STAGE(PG8_SA(0, 0), a2, voffA);
            PG8_BAR; PG8_WAIT_L(0); PG8_MMA(1, 0, At, B0); PG8_BAR; PG8_SCHED;
            PG8_STAGE(PG8_SB(0, 1), b2 + hstep, voffB);
            PG8_WAIT_V(6); PG8_BAR; PG8_MMA(1, 1, At, B1); PG8_BAR;
            PG8_LDB(B0, 1, 0); PG8_SCHED; PG8_LDA(At, 1, 0); PG8_STAGE(PG8_SA(0, 1), a2 + hstep, voffA);
            PG8_WAIT_L(8); PG8_BAR; PG8_WAIT_L(0); PG8_MMA(0, 0, At, B0); PG8_BAR; PG8_SCHED;
            PG8_LDB(B1, 1, 1); PG8_STAGE(PG8_SB(1, 0), b3, voffB);
            PG8_BAR; PG8_WAIT_L(0); PG8_MMA(0, 1, At, B1); PG8_BAR;
            PG8_LDA(At, 1, 1); PG8_STAGE(PG8_SA(1, 0), a3, voffA);
            PG8_BAR; PG8_WAIT_L(0); PG8_MMA(1, 0, At, B0); PG8_BAR; PG8_SCHED;
            PG8_STAGE(PG8_SB(1, 1), b3 + hstep, voffB);
            PG8_WAIT_V(6); PG8_BAR; PG8_MMA(1, 1, At, B1); PG8_BAR;
            }
        }
        if constexpr (ALIGN_EPI) { if (wr == 0) PG8_BAR; }
        if constexpr (!Epi::AFTER_DRAIN) { if (ui == 0) E.pre_store(lane); E(acc, cur, wr, wc, fr, fq); S.done(cur); }
        if (!has_next) break;
        if (!(Epi::KEEP_ACC && nxt.z != 0)) {
#pragma unroll
        for (int a = 0; a < 2; ++a)
#pragma unroll
            for (int b = 0; b < 2; ++b)
#pragma unroll
                for (int m = 0; m < 4; ++m)
#pragma unroll
                    for (int n = 0; n < 2; ++n) acc[a][b][m][n] = (f32x4){0.f, 0.f, 0.f, 0.f};
        }
        cur = nxt; cA = nA; cB = nB; ++ui;
        if constexpr (ALIGN_EPI) { if (wr == 1) PG8_BAR; }
    }
    PG8_WAIT_V(0);
    if constexpr (!ALIGN_EPI) { if (wr == 0) PG8_BAR; }
    PG8_BAR;
    if constexpr (Epi::AFTER_DRAIN) { E.fused(acc, cur, wr, wc, fr, fq, lds, wid, lane); S.done(cur); }
#undef PG8_SA
#undef PG8_SB
#undef PG8_STAGE
#undef PG8_LDA
#undef PG8_LDB
#undef PG8_MMA
#undef PG8_WAIT_V
#undef PG8_WAIT_L
#undef PG8_BAR
#undef PG8_SCHED
}
}
namespace attn {
using bf16x8 = __attribute__((ext_vector_type(8))) short;
using s16x4 = __attribute__((ext_vector_type(4))) short;
using f32x16 = __attribute__((ext_vector_type(16))) float;
using f32x4 = __attribute__((ext_vector_type(4))) float;
using u32x4 = __attribute__((ext_vector_type(4))) unsigned;
typedef unsigned short bf16;
constexpr int SEQ = 2048, DM = 512, NW = 8, QBLK = 32, QB = QBLK * NW, KVBLK = 64;
constexpr int SLOTB = 8192, LDS_K = 0, LDS_V = 3 * SLOTB, LDS_WS = 6 * SLOTB, LDS_OST = LDS_WS + NW * 256, LDS_BIAS = LDS_OST + NW * 4096, LDS_BYTES = LDS_BIAS + SEQ * 4;
constexpr int THR = 64;
#define SBAR() __builtin_amdgcn_sched_barrier(0)
#define PIN(x) asm volatile("" : "+v"(x))
#define MFMA(a, b, c) __builtin_amdgcn_mfma_f32_32x32x16_bf16(a, b, c, 0, 0, 0)
#define WAIT_BAR(N) asm volatile("s_waitcnt vmcnt(" #N ") lgkmcnt(0)\n\ts_barrier" ::: "memory")
__device__ __forceinline__ int crow(int r, int hi) { return (r & 3) + 8 * (r >> 2) + 4 * hi; }
__device__ __forceinline__ unsigned cvtpk(float lo, float hi) { unsigned r; asm("v_cvt_pk_bf16_f32 %0, %1, %2" : "=v"(r) : "v"(lo), "v"(hi)); return r; }
__device__ __forceinline__ void glds16(const void* g, unsigned lds_base) {
    unsigned sv; asm volatile("s_mov_b32 %0, m0\n\ts_mov_b32 m0, %2\n\ts_nop 0\n\tglobal_load_lds_dwordx4 %1, off\n\ts_mov_b32 m0, %0" : "=&s"(sv) : "v"(g), "s"(lds_base) : "memory"); }
typedef __attribute__((address_space(3))) const char* lds_cptr;
typedef short v4i16_t __attribute__((ext_vector_type(4)));
__device__ __forceinline__ void kload2(bf16x8* kf, lds_cptr kp, int d0) { kf[2 * d0] = *(const __attribute__((address_space(3))) bf16x8*)(kp + d0 * 2048); kf[2 * d0 + 1] = *(const __attribute__((address_space(3))) bf16x8*)(kp + d0 * 2048 + 512); }
__device__ __forceinline__ s16x4 vtr(lds_cptr p) { return __builtin_bit_cast(s16x4, __builtin_amdgcn_ds_read_tr16_b64_v4i16((__attribute__((address_space(3))) v4i16_t*)p)); }
#define MX3(a, b, c) __builtin_fmaxf(__builtin_fmaxf((a), (b)), (c))
__device__ __forceinline__ float rowmax(const f32x16& p0, const f32x16& p1) {
    float a = MX3(p0[0], p0[1], p1[0]), b = MX3(p0[2], p0[3], p1[1]); a = MX3(a, p1[2], p1[3]);
#pragma unroll
    for (int r = 4; r < 16; r += 4) { a = MX3(a, p0[r], p0[r + 1]); b = MX3(b, p0[r + 2], p0[r + 3]); a = MX3(a, p1[r], p1[r + 1]); b = MX3(b, p1[r + 2], p1[r + 3]); }
    float m = __builtin_fmaxf(a, b); auto rr = __builtin_amdgcn_permlane32_swap(__float_as_uint(m), __float_as_uint(m), false, false);
    return __builtin_fmaxf(__uint_as_float(rr[0]), __uint_as_float(rr[1])); }
__device__ __forceinline__ void cmask(f32x16& p0, f32x16& p1, int jb, int qrel, int hi) {
    const int kb = 64 * jb + 4 * hi;
#pragma unroll
    for (int r = 0; r < 16; ++r) { const int kv = kb + (r & 3) + 8 * (r >> 2); if (kv > qrel) p0[r] = -INFINITY; if (kv + 32 > qrel) p1[r] = -INFINITY; } }
typedef __attribute__((address_space(3))) const f32x4* lds_f4ptr;
__device__ __forceinline__ void ldbias(f32x16& p0, f32x16& p1, lds_cptr bp) {
    lds_f4ptr b = (lds_f4ptr)bp;
    const f32x4 a0 = b[0], a1 = b[2], a2 = b[4], a3 = b[6], c0 = b[8], c1 = b[10], c2 = b[12], c3 = b[14];
    p0 = (f32x16){a0[0], a0[1], a0[2], a0[3], a1[0], a1[1], a1[2], a1[3], a2[0], a2[1], a2[2], a2[3], a3[0], a3[1], a3[2], a3[3]};
    p1 = (f32x16){c0[0], c0[1], c0[2], c0[3], c1[0], c1[1], c1[2], c1[3], c2[0], c2[1], c2[2], c2[3], c3[0], c3[1], c3[2], c3[3]};
}

constexpr int LDS2_V = 3 * SLOTB, LDS2_WS = LDS2_V + 6 * SLOTB, LDS2_OST = LDS2_WS + NW * 256, LDS2_BIAS = LDS2_OST + NW * 4096, LDS2_Q = LDS2_BIAS + SEQ * 4, LDS2_BYTES = LDS2_Q + NW * 4096;
__device__ __forceinline__ void attn_unit(const bf16* Q, const bf16* __restrict__ K, const bf16* __restrict__ V, bf16* O, int qb, int T0, char* lds) {
    int tid_ = threadIdx.x; asm volatile("" : "+v"(tid_));
    const int tid = tid_, lane = tid & 63, r32 = lane & 31, hi = lane >> 5; const int wid = __builtin_amdgcn_readfirstlane(tid >> 6);
    const int q0 = qb * QB, NT = (q0 + QB) / KVBLK - T0;
    const bf16* Qw = Q + (long)(q0 + wid * QBLK) * DM;
    const unsigned lds0 = (unsigned)(uintptr_t)lds; float* wsf = (float*)(lds + LDS_WS) + wid * 64;
    const bf16* ksrc = K + (long)(T0 * KVBLK + lane) * DM + wid * 8;
    const bf16* vsrc = V + (long)(T0 * KVBLK + 16 * (wid & 3) + (lane >> 2)) * DM + (wid >> 2) * 32 + (lane & 3) * 8;
    const unsigned kdst = lds0 + LDS_K + wid * 1024, vdst = lds0 + LDS_V + wid * 1024;
#define DMA_K(t, slot) glds16(ksrc + (long)(t) * KVBLK * DM, (unsigned)__builtin_amdgcn_readfirstlane(kdst + (slot)))
#define DMA_V(t, slot) glds16(vsrc + (long)(t) * KVBLK * DM, (unsigned)__builtin_amdgcn_readfirstlane(vdst + (slot)))
    const lds_cptr vp0 = (lds_cptr)lds + LDS_V + ((lane >> 4) & 1) * 32 + (lane & 3) * 8 + (4 * hi + ((lane & 15) >> 2)) * 64;
    const lds_cptr kp0 = (lds_cptr)lds + LDS_K + hi * 1024 + r32 * 16;
    const lds_cptr bp0 = (lds_cptr)lds + LDS_BIAS + T0 * 256 + hi * 16;
    DMA_K(0, 0); DMA_V(0, 0); DMA_K(1, SLOTB);
    bf16x8 qr[4];
#pragma unroll
    for (int d0 = 0; d0 < 4; ++d0) qr[d0] = *reinterpret_cast<const bf16x8*>(&Qw[(long)r32 * DM + d0 * 16 + hi * 8]);
    float mhat = 0.f, l_reg = 0.f; f32x16 o[2]; o[0] = f32x16{}; o[1] = f32x16{};
    const int qrel = wid * QBLK + r32; bool resc = false;
    f32x16 pA0, pA1, pB0, pB1; bf16x8 kf[8]; s16x4 vlo[8], vhi[8]; u32x4 pw0, pw1, pw2, pw3;
    int sl_prev = 0, sl_cur = 0, sl_next = SLOTB;
#define ROT() do { sl_prev = sl_cur; sl_cur = sl_next; sl_next = (sl_next == 2 * SLOTB) ? 0 : sl_next + SLOTB; } while (0)
#define EX(v) __builtin_amdgcn_exp2f((v) + nmh)
#define RESC() do { if (resc) { _Pragma("unroll") for (int d_ = 0; d_ < 2; ++d_) _Pragma("unroll") for (int r = 0; r < 16; ++r) o[d_][r] *= wsf[crow(r, hi)]; } } while (0)
    DMA_K(2, 2 * SLOTB);
    ldbias(pA0, pA1, bp0);
    WAIT_BAR(3);
    _Pragma("unroll") for (int d0 = 0; d0 < 4; ++d0) kload2(kf, kp0, d0);
    pA0 = MFMA(kf[0], qr[0], pA0); pA1 = MFMA(kf[1], qr[0], pA1); pA0 = MFMA(kf[2], qr[1], pA0); pA1 = MFMA(kf[3], qr[1], pA1);
    pA0 = MFMA(kf[4], qr[2], pA0); pA1 = MFMA(kf[5], qr[2], pA1); pA0 = MFMA(kf[6], qr[3], pA0); pA1 = MFMA(kf[7], qr[3], pA1);
    if (NT == 4) cmask(pA0, pA1, 0, qrel, hi);
    { const float rm = rowmax(pA0, pA1); mhat = rm; const float nmh = -mhat;
#pragma unroll
      for (int r = 0; r < 16; ++r) { pA0[r] = EX(pA0[r]); pA1[r] = EX(pA1[r]); } }
    ldbias(pB0, pB1, bp0 + 256);
    WAIT_BAR(0);
    DMA_K(3, 0); DMA_V(1, SLOTB); ROT();
    _Pragma("unroll") for (int d0 = 0; d0 < 4; ++d0) kload2(kf, kp0 + sl_cur, d0);
    WAIT_BAR(2);
#define PKW(P, i) cvtpk(P[i], P[i + 1])
#define PAF(k) __builtin_bit_cast(bf16x8, pw##k)
#define VFR(i) (bf16x8){vlo[i][0], vlo[i][1], vlo[i][2], vlo[i][3], vhi[i][0], vhi[i][1], vhi[i][2], vhi[i][3]}
#define VRD(i) do { vlo[i] = vtr(vp_ + (((i) >> 2) * 4096 + ((i) & 3) * 1024)); vhi[i] = vtr(vp_ + (((i) >> 2) * 4096 + ((i) & 3) * 1024 + 512)); } while (0)
#define KRD(G, d0) do { if (G) { kload2(kf, kp0 + sl_next, d0); SBAR(); } } while (0)
#define GAPA(MF, a0, a1, a2, a3, W0, W1, PW) do { MF; sacc += a0; sacc += a1; sacc += a2; sacc += a3; W0; W1; PIN(PW); PIN(sacc); SBAR(); } while (0)
#define GAPB(MF, X, i) do { MF; X[i] = EX(X[i]); X[i + 1] = EX(X[i + 1]); X[i + 2] = EX(X[i + 2]); X[i + 3] = EX(X[i + 3]); PIN(X); SBAR(); } while (0)
#define STEP(C0, C1, P0, P1, t, MASK, GK, GV, GL, GB) do { SBAR(); \
    const lds_cptr vp_ = vp0 + sl_prev; \
    VRD(0); SBAR(); float sacc = P0[0] + P0[1]; \
                    GAPA(C0 = MFMA(kf[0], qr[0], C0), P0[2], P0[3], P0[4], P0[5],     pw0[0] = PKW(P0, 0),  pw0[1] = PKW(P0, 2),  pw0); \
    VRD(4); SBAR(); GAPA(C1 = MFMA(kf[1], qr[0], C1), P0[6], P0[7], P0[8], P0[9],     pw0[2] = PKW(P0, 4),  pw0[3] = PKW(P0, 6),  pw0); \
    VRD(1); SBAR(); GAPA(C0 = MFMA(kf[2], qr[1], C0),    P0[10], P0[11], P0[12], P0[13], pw1[0] = PKW(P0, 8),  pw1[1] = PKW(P0, 10), pw1); \
    VRD(5); SBAR(); GAPA(C1 = MFMA(kf[3], qr[1], C1),    P0[14], P0[15], P1[0], P1[1],   pw1[2] = PKW(P0, 12), pw1[3] = PKW(P0, 14), pw1); \
    VRD(2); SBAR(); GAPA(C0 = MFMA(kf[4], qr[2], C0),    P1[2], P1[3], P1[4], P1[5],     pw2[0] = PKW(P1, 0),  pw2[1] = PKW(P1, 2),  pw2); \
    VRD(6); SBAR(); GAPA(C1 = MFMA(kf[5], qr[2], C1),    P1[6], P1[7], P1[8], P1[9],     pw2[2] = PKW(P1, 4),  pw2[3] = PKW(P1, 6),  pw2); \
    VRD(3); SBAR(); GAPA(C0 = MFMA(kf[6], qr[3], C0),    P1[10], P1[11], P1[12], P1[13], pw3[0] = PKW(P1, 8),  pw3[1] = PKW(P1, 10), pw3); \
    VRD(7); SBAR(); GAPA(C1 = MFMA(kf[7], qr[3], C1),    P1[14], P1[15], 0.f, 0.f,       pw3[2] = PKW(P1, 12), pw3[3] = PKW(P1, 14), pw3); \
    l_reg += sacc; \
    if (GK) DMA_K((t) + 3, sl_cur); if (GV) DMA_V((t) + 1, sl_next); \
    if (MASK) cmask(C0, C1, (t) - (NT - 4), qrel, hi); \
    { const float rm = rowmax(C0, C1) - mhat; resc = false; \
      if (__builtin_expect(__any(rm > (float)THR), 0)) { const float dl = __builtin_fmaxf(rm, 0.f); mhat += dl; \
          const float f = __builtin_amdgcn_exp2f(-dl); l_reg *= f; if (hi == 0) wsf[r32] = f; resc = true; } } \
    const float nmh = -mhat; SBAR(); \
    GAPB(o[0] = MFMA(PAF(0), VFR(0), o[0]), C0, 0);              GAPB(o[1] = MFMA(PAF(0), VFR(4), o[1]), C0, 4); \
    KRD(GL, 0); GAPB(o[0] = MFMA(PAF(1), VFR(1), o[0]), C0, 8);  KRD(GL, 1); GAPB(o[1] = MFMA(PAF(1), VFR(5), o[1]), C0, 12); \
    KRD(GL, 2); GAPB(o[0] = MFMA(PAF(2), VFR(2), o[0]), C1, 0);  KRD(GL, 3); GAPB(o[1] = MFMA(PAF(2), VFR(6), o[1]), C1, 4); \
    GAPB(o[0] = MFMA(PAF(3), VFR(3), o[0]), C1, 8);              GAPB(o[1] = MFMA(PAF(3), VFR(7), o[1]), C1, 12); \
    if (GB) ldbias(P0, P1, bp0 + ((t) + 1) * 256); \
    } while (0)
    int t = 1;
    for (; t + 5 < NT; t += 2) {
        STEP(pB0, pB1, pA0, pA1, t, false, true, true, true, true);     WAIT_BAR(2); RESC(); ROT();
        STEP(pA0, pA1, pB0, pB1, t + 1, false, true, true, true, true); WAIT_BAR(2); RESC(); ROT();
    }
#define ENDW(tt) do { if ((tt) + 3 < NT) { WAIT_BAR(2); } else if ((tt) + 2 < NT) { WAIT_BAR(1); } else { WAIT_BAR(0); } } while (0)
    for (; t + 1 < NT; t += 2) {
        STEP(pB0, pB1, pA0, pA1, t, true, (t + 3 < NT), (t + 1 < NT), (t + 1 < NT), true);         ENDW(t);     RESC(); ROT();
        STEP(pA0, pA1, pB0, pB1, t + 1, true, (t + 4 < NT), (t + 2 < NT), (t + 2 < NT), (t + 2 < NT));     ENDW(t + 1); RESC(); ROT();
    }
    STEP(pB0, pB1, pA0, pA1, NT - 1, true, false, false, false, false); RESC();
    { float sacc = pB0[0] + pB0[1];
#pragma unroll
      for (int r = 2; r < 16; ++r) sacc += pB0[r];
#pragma unroll
      for (int r = 0; r < 16; ++r) sacc += pB1[r];
      l_reg += sacc;
      pw0 = (u32x4){PKW(pB0, 0), PKW(pB0, 2), PKW(pB0, 4), PKW(pB0, 6)}; pw1 = (u32x4){PKW(pB0, 8), PKW(pB0, 10), PKW(pB0, 12), PKW(pB0, 14)};
      pw2 = (u32x4){PKW(pB1, 0), PKW(pB1, 2), PKW(pB1, 4), PKW(pB1, 6)}; pw3 = (u32x4){PKW(pB1, 8), PKW(pB1, 10), PKW(pB1, 12), PKW(pB1, 14)};
      const lds_cptr vp_ = vp0 + sl_cur; _Pragma("unroll") for (int i = 0; i < 8; ++i) VRD(i);
      o[0] = MFMA(PAF(0), VFR(0), o[0]); o[1] = MFMA(PAF(0), VFR(4), o[1]); o[0] = MFMA(PAF(1), VFR(1), o[0]); o[1] = MFMA(PAF(1), VFR(5), o[1]);
      o[0] = MFMA(PAF(2), VFR(2), o[0]); o[1] = MFMA(PAF(2), VFR(6), o[1]); o[0] = MFMA(PAF(3), VFR(3), o[0]); o[1] = MFMA(PAF(3), VFR(7), o[1]); }
    { auto rr = __builtin_amdgcn_permlane32_swap(__float_as_uint(l_reg), __float_as_uint(l_reg), false, false); l_reg = __uint_as_float(rr[0]) + __uint_as_float(rr[1]); }
    if (hi == 0) wsf[32 + r32] = l_reg; asm volatile("s_waitcnt lgkmcnt(0)" ::: "memory");
    float rli[16];
#pragma unroll
    for (int r = 0; r < 16; ++r) rli[r] = __builtin_amdgcn_rcpf(wsf[32 + crow(r, hi)]);
    bf16* Ow = O + (long)(q0 + wid * QBLK) * DM; bf16* stg = (bf16*)(lds + LDS_OST) + wid * 2048;
#pragma unroll
    for (int r = 0; r < 16; r += 1) { const int orow = crow(r, hi);
#pragma unroll
        for (int d0 = 0; d0 < 2; ++d0) { const unsigned pk = cvtpk(o[d0][r] * rli[r], 0.f); stg[orow * 64 + d0 * 32 + r32] = (bf16)(pk & 0xffffu); } }
    asm volatile("s_waitcnt lgkmcnt(0)" ::: "memory");
#pragma unroll
    for (int i = 0; i < 4; ++i) { const int row = i * 8 + (lane >> 3), ch = lane & 7; *(u32x4*)(Ow + (long)row * DM + ch * 8) = *(const u32x4*)(stg + row * 64 + ch * 8); }
    asm volatile("s_waitcnt lgkmcnt(0)\n\ts_barrier" ::: "memory");
#undef DMA_K
#undef DMA_V
#undef ROT
#undef EX
#undef RESC
#undef PKW
#undef PAF
#undef VFR
#undef VRD
#undef KRD
#undef ENDW
#undef GAPA
#undef GAPB
#undef STEP
}
__device__ __forceinline__ void attn_unit2(const bf16* Q, const bf16* __restrict__ K, const bf16* __restrict__ V, bf16* O, int qb, int T0, char* lds) {
    int tid_ = threadIdx.x; asm volatile("" : "+v"(tid_));
    const int tid = tid_, lane = tid & 63, r32 = lane & 31, hi = lane >> 5; const int wid = __builtin_amdgcn_readfirstlane(tid >> 6);
    const int q0 = qb * QB, NT = (q0 + QB) / KVBLK - T0;
    const bf16* Qw = Q + (long)(q0 + wid * QBLK) * DM;
    const unsigned lds0 = (unsigned)(uintptr_t)lds; float* wsf = (float*)(lds + LDS2_WS) + wid * 64;
    const bf16* ksrc = K + (long)(T0 * KVBLK + lane) * DM + wid * 8;
    const bf16* vsrc = V + (long)(T0 * KVBLK + 16 * (wid & 3) + (lane >> 2)) * DM + (wid >> 2) * 32 + (lane & 3) * 8;
    const unsigned kdst = lds0 + LDS_K + wid * 1024, vdst = lds0 + LDS2_V + wid * 1024;
#define DMA_K(t, slot) glds16(ksrc + (long)(t) * KVBLK * DM, (unsigned)__builtin_amdgcn_readfirstlane(kdst + (slot)))
#define DMA_V(t, slot) do { glds16(vsrc + (long)(t) * KVBLK * DM, (unsigned)__builtin_amdgcn_readfirstlane(vdst + 2 * (slot))); glds16(vsrc + (long)(t) * KVBLK * DM + 64, (unsigned)__builtin_amdgcn_readfirstlane(vdst + 2 * (slot) + 8192)); } while (0)
    const lds_cptr vp0 = (lds_cptr)lds + LDS2_V + ((lane >> 4) & 1) * 32 + (lane & 3) * 8 + (4 * hi + ((lane & 15) >> 2)) * 64;
    const lds_cptr kp0 = (lds_cptr)lds + LDS_K + hi * 1024 + r32 * 16;
    const lds_cptr bp0 = (lds_cptr)lds + LDS2_BIAS + T0 * 256 + hi * 16;
    DMA_K(0, 0); DMA_V(0, 0); DMA_K(1, SLOTB);
    bf16x8 qr[4];
#pragma unroll
    for (int d0 = 0; d0 < 4; ++d0) qr[d0] = *reinterpret_cast<const bf16x8*>(&Qw[(long)r32 * DM + d0 * 16 + hi * 8]);
    const lds_cptr qp0 = (lds_cptr)lds + LDS2_Q + wid * 4096 + hi * 512 + r32 * 16;
#pragma unroll
    for (int d0 = 0; d0 < 4; ++d0) *(__attribute__((address_space(3))) bf16x8*)(qp0 + d0 * 1024) = qr[d0];
    float mhat = 0.f, l_reg = 0.f; f32x16 o[4]; o[0] = f32x16{}; o[1] = f32x16{}; o[2] = f32x16{}; o[3] = f32x16{};
    const int qrel = wid * QBLK + r32; bool resc = false;
    f32x16 pA0, pA1, pB0, pB1; s16x4 vl0, vh0, vl1, vh1; u32x4 pw0, pw1, pw2, pw3;
    int sl_prev = 0, sl_cur = 0, sl_next = SLOTB;
#define ROT() do { sl_prev = sl_cur; sl_cur = sl_next; sl_next = (sl_next == 2 * SLOTB) ? 0 : sl_next + SLOTB; } while (0)
#define EX(v) __builtin_amdgcn_exp2f((v) + nmh)
#define RESC() do { if (resc) { _Pragma("unroll") for (int d_ = 0; d_ < 4; ++d_) _Pragma("unroll") for (int r = 0; r < 16; ++r) o[d_][r] *= wsf[crow(r, hi)]; } } while (0)
    DMA_K(2, 2 * SLOTB);
    ldbias(pA0, pA1, bp0);
    WAIT_BAR(4);
    { bf16x8 kf[8];
    _Pragma("unroll") for (int d0 = 0; d0 < 4; ++d0) kload2(kf, kp0, d0);
    pA0 = MFMA(kf[0], qr[0], pA0); pA1 = MFMA(kf[1], qr[0], pA1); pA0 = MFMA(kf[2], qr[1], pA0); pA1 = MFMA(kf[3], qr[1], pA1);
    pA0 = MFMA(kf[4], qr[2], pA0); pA1 = MFMA(kf[5], qr[2], pA1); pA0 = MFMA(kf[6], qr[3], pA0); pA1 = MFMA(kf[7], qr[3], pA1); }
    if (NT == 4) cmask(pA0, pA1, 0, qrel, hi);
    { const float rm = rowmax(pA0, pA1); mhat = rm; const float nmh = -mhat;
#pragma unroll
      for (int r = 0; r < 16; ++r) { pA0[r] = EX(pA0[r]); pA1[r] = EX(pA1[r]); } }
    WAIT_BAR(0);
    DMA_V(1, SLOTB); ROT();
    WAIT_BAR(2);
#define PKW(P, i) cvtpk(P[i], P[i + 1])
#define PAF(k) __builtin_bit_cast(bf16x8, pw##k)
#define VOFF(i, hf) ((hf) * 8192 + ((i) >> 2) * 4096 + ((i) & 3) * 1024)
#define VLD(S, i, hf) do { vl##S = vtr(vp_ + VOFF(i, hf)); vh##S = vtr(vp_ + VOFF(i, hf) + 512); } while (0)
#define VF(S) (bf16x8){vl##S[0], vl##S[1], vl##S[2], vl##S[3], vh##S[0], vh##S[1], vh##S[2], vh##S[3]}
#define KRD(G, d0) do { if (G) { kload2(kf, kp0 + sl_next, d0); SBAR(); } } while (0)
#define GAPA(MF, a0, a1, a2, a3, W0, W1, PW) do { MF; sacc += a0; sacc += a1; sacc += a2; sacc += a3; W0; W1; PIN(PW); PIN(sacc); SBAR(); } while (0)
#define QLD(d0) (*(const __attribute__((address_space(3))) bf16x8*)(qp0 + (d0) * 1024))
#define GAPC(MF) do { MF; SBAR(); } while (0)
#define GAPB(MF, X, i) do { MF; X[i] = EX(X[i]); X[i + 1] = EX(X[i + 1]); X[i + 2] = EX(X[i + 2]); X[i + 3] = EX(X[i + 3]); PIN(X); SBAR(); } while (0)
#define STEP(C0, C1, P0, P1, t, MASK, GK, GV, GL, GB) do { SBAR(); \
    if (GK) DMA_K((t) + 2, sl_prev); \
    ldbias(C0, C1, bp0 + (t) * 256); \
    const lds_cptr vp_ = vp0 + 2 * sl_prev; \
    bf16x8 qa_ = QLD(0); float sacc = P0[0] + P0[1]; \
    { bf16x8 kf[8]; _Pragma("unroll") for (int d0_ = 0; d0_ < 4; ++d0_) kload2(kf, kp0 + sl_cur, d0_); \
    GAPA(C0 = MFMA(kf[0], qa_, C0), P0[2], P0[3], P0[4], P0[5],     pw0[0] = PKW(P0, 0),  pw0[1] = PKW(P0, 2),  pw0); \
    GAPA(C1 = MFMA(kf[1], qa_, C1), P0[6], P0[7], P0[8], P0[9],     pw0[2] = PKW(P0, 4),  pw0[3] = PKW(P0, 6),  pw0); \
    qa_ = QLD(1); SBAR(); \
    GAPA(C0 = MFMA(kf[2], qa_, C0),    P0[10], P0[11], P0[12], P0[13], pw1[0] = PKW(P0, 8),  pw1[1] = PKW(P0, 10), pw1); \
    GAPA(C1 = MFMA(kf[3], qa_, C1),    P0[14], P0[15], P1[0], P1[1],   pw1[2] = PKW(P0, 12), pw1[3] = PKW(P0, 14), pw1); \
    qa_ = QLD(2); SBAR(); \
    GAPA(C0 = MFMA(kf[4], qa_, C0),    P1[2], P1[3], P1[4], P1[5],     pw2[0] = PKW(P1, 0),  pw2[1] = PKW(P1, 2),  pw2); \
    GAPA(C1 = MFMA(kf[5], qa_, C1),    P1[6], P1[7], P1[8], P1[9],     pw2[2] = PKW(P1, 4),  pw2[3] = PKW(P1, 6),  pw2); \
    qa_ = QLD(3); SBAR(); \
    GAPA(C0 = MFMA(kf[6], qa_, C0),    P1[10], P1[11], P1[12], P1[13], pw3[0] = PKW(P1, 8),  pw3[1] = PKW(P1, 10), pw3); \
    GAPA(C1 = MFMA(kf[7], qa_, C1),    P1[14], P1[15], 0.f, 0.f,       pw3[2] = PKW(P1, 12), pw3[3] = PKW(P1, 14), pw3); } \
    l_reg += sacc; \
    if (GV) DMA_V((t) + 1, sl_next); \
    if (MASK) cmask(C0, C1, (t) - (NT - 4), qrel, hi); \
    { const float rm = rowmax(C0, C1) - mhat; resc = false; \
      if (__builtin_expect(__any(rm > (float)THR), 0)) { const float dl = __builtin_fmaxf(rm, 0.f); mhat += dl; \
          const float f = __builtin_amdgcn_exp2f(-dl); l_reg *= f; if (hi == 0) wsf[r32] = f; resc = true; } } \
    const float nmh = -mhat; SBAR(); \
    VLD(0, 0, 0); SBAR(); \
    GAPB(o[0] = MFMA(PAF(0), VF(0), o[0]), C0, 0);  VLD(1, 4, 0); SBAR(); \
    GAPB(o[1] = MFMA(PAF(0), VF(1), o[1]), C0, 4);  VLD(0, 1, 0); SBAR(); \
    GAPB(o[0] = MFMA(PAF(1), VF(0), o[0]), C0, 8);  VLD(1, 5, 0); SBAR(); \
    GAPB(o[1] = MFMA(PAF(1), VF(1), o[1]), C0, 12);  VLD(0, 2, 0); SBAR(); \
    GAPB(o[0] = MFMA(PAF(2), VF(0), o[0]), C1, 0);  VLD(1, 6, 0); SBAR(); \
    GAPB(o[1] = MFMA(PAF(2), VF(1), o[1]), C1, 4);  VLD(0, 3, 0); SBAR(); \
    GAPB(o[0] = MFMA(PAF(3), VF(0), o[0]), C1, 8);  VLD(1, 7, 0); SBAR(); \
    GAPB(o[1] = MFMA(PAF(3), VF(1), o[1]), C1, 12);  VLD(0, 0, 1); SBAR(); \
    GAPC(o[2] = MFMA(PAF(0), VF(0), o[2]));  VLD(1, 4, 1); SBAR(); \
    GAPC(o[3] = MFMA(PAF(0), VF(1), o[3]));  VLD(0, 1, 1); SBAR(); \
    GAPC(o[2] = MFMA(PAF(1), VF(0), o[2]));  VLD(1, 5, 1); SBAR(); \
    GAPC(o[3] = MFMA(PAF(1), VF(1), o[3]));  VLD(0, 2, 1); SBAR(); \
    GAPC(o[2] = MFMA(PAF(2), VF(0), o[2]));  VLD(1, 6, 1); SBAR(); \
    GAPC(o[3] = MFMA(PAF(2), VF(1), o[3]));  VLD(0, 3, 1); SBAR(); \
    GAPC(o[2] = MFMA(PAF(3), VF(0), o[2]));  VLD(1, 7, 1); SBAR(); \
    GAPC(o[3] = MFMA(PAF(3), VF(1), o[3]));  \
    } while (0)
    int t = 1;
    for (; t + 5 < NT; t += 2) {
        STEP(pB0, pB1, pA0, pA1, t, false, true, true, true, true);     WAIT_BAR(3); RESC(); ROT();
        STEP(pA0, pA1, pB0, pB1, t + 1, false, true, true, true, true); WAIT_BAR(3); RESC(); ROT();
    }
#define ENDW(tt) do { if ((tt) + 2 < NT) { WAIT_BAR(3); } else { WAIT_BAR(0); } } while (0)
    for (; t + 1 < NT; t += 2) {
        STEP(pB0, pB1, pA0, pA1, t, true, (t + 2 < NT), (t + 1 < NT), (t + 1 < NT), true);         ENDW(t);     RESC(); ROT();
        STEP(pA0, pA1, pB0, pB1, t + 1, true, (t + 3 < NT), (t + 2 < NT), (t + 2 < NT), (t + 2 < NT));     ENDW(t + 1); RESC(); ROT();
    }
    STEP(pB0, pB1, pA0, pA1, NT - 1, true, false, false, false, false); RESC();
    { float sacc = pB0[0] + pB0[1];
#pragma unroll
      for (int r = 2; r < 16; ++r) sacc += pB0[r];
#pragma unroll
      for (int r = 0; r < 16; ++r) sacc += pB1[r];
      l_reg += sacc;
      pw0 = (u32x4){PKW(pB0, 0), PKW(pB0, 2), PKW(pB0, 4), PKW(pB0, 6)}; pw1 = (u32x4){PKW(pB0, 8), PKW(pB0, 10), PKW(pB0, 12), PKW(pB0, 14)};
      pw2 = (u32x4){PKW(pB1, 0), PKW(pB1, 2), PKW(pB1, 4), PKW(pB1, 6)}; pw3 = (u32x4){PKW(pB1, 8), PKW(pB1, 10), PKW(pB1, 12), PKW(pB1, 14)};
      const lds_cptr vp_ = vp0 + 2 * sl_cur;
#pragma unroll
      for (int hf = 0; hf < 2; ++hf) { s16x4 dl[8], dh[8];
#pragma unroll
          for (int i = 0; i < 8; ++i) { dl[i] = vtr(vp_ + VOFF(i, hf)); dh[i] = vtr(vp_ + VOFF(i, hf) + 512); }
#define DF(i) (bf16x8){dl[i][0], dl[i][1], dl[i][2], dl[i][3], dh[i][0], dh[i][1], dh[i][2], dh[i][3]}
          o[2 * hf] = MFMA(PAF(0), DF(0), o[2 * hf]); o[2 * hf + 1] = MFMA(PAF(0), DF(4), o[2 * hf + 1]); o[2 * hf] = MFMA(PAF(1), DF(1), o[2 * hf]); o[2 * hf + 1] = MFMA(PAF(1), DF(5), o[2 * hf + 1]);
          o[2 * hf] = MFMA(PAF(2), DF(2), o[2 * hf]); o[2 * hf + 1] = MFMA(PAF(2), DF(6), o[2 * hf + 1]); o[2 * hf] = MFMA(PAF(3), DF(3), o[2 * hf]); o[2 * hf + 1] = MFMA(PAF(3), DF(7), o[2 * hf + 1]);
#undef DF
      } }
    { auto rr = __builtin_amdgcn_permlane32_swap(__float_as_uint(l_reg), __float_as_uint(l_reg), false, false); l_reg = __uint_as_float(rr[0]) + __uint_as_float(rr[1]); }
    if (hi == 0) wsf[32 + r32] = l_reg; asm volatile("s_waitcnt lgkmcnt(0)" ::: "memory");
    float rli[16];
#pragma unroll
    for (int r = 0; r < 16; ++r) rli[r] = __builtin_amdgcn_rcpf(wsf[32 + crow(r, hi)]);
    bf16* Ow = O + (long)(q0 + wid * QBLK) * DM; bf16* stg = (bf16*)(lds + LDS2_OST) + wid * 2048;
#pragma unroll
    for (int hf = 0; hf < 2; ++hf) {
#pragma unroll
        for (int r = 0; r < 16; r += 1) { const int orow = crow(r, hi);
#pragma unroll
            for (int d0 = 0; d0 < 2; ++d0) { const unsigned pk = cvtpk(o[2 * hf + d0][r] * rli[r], 0.f); stg[orow * 64 + d0 * 32 + r32] = (bf16)(pk & 0xffffu); } }
        asm volatile("s_waitcnt lgkmcnt(0)" ::: "memory");
#pragma unroll
        for (int i = 0; i < 4; ++i) { const int row = i * 8 + (lane >> 3), ch = lane & 7; *(u32x4*)(Ow + (long)row * DM + 64 * hf + ch * 8) = *(const u32x4*)(stg + row * 64 + ch * 8); }
        asm volatile("s_waitcnt lgkmcnt(0)" ::: "memory"); }
    asm volatile("s_waitcnt lgkmcnt(0)\n\ts_barrier" ::: "memory");
#undef DMA_K
#undef DMA_V
#undef ROT
#undef EX
#undef RESC
#undef PKW
#undef PAF
#undef VF
#undef VLD
#undef VOFF
#undef KRD
#undef ENDW
#undef GAPA
#undef GAPB
#undef GAPC
#undef QLD
#undef STEP
}
#undef SBAR
#undef PIN
#undef MFMA
#undef WAIT_BAR
#undef MX3
}
#define GAS __attribute__((address_space(1)))
#define LAS __attribute__((address_space(3)))
typedef unsigned short bf16;
typedef unsigned v4u __attribute__((ext_vector_type(4)));
typedef unsigned v2u __attribute__((ext_vector_type(2)));
typedef float f32x4 __attribute__((ext_vector_type(4)));
typedef short bf16x8 __attribute__((ext_vector_type(8)));
typedef short v4i16 __attribute__((ext_vector_type(4)));
using pg8::pkbf; using pg8::bflo; using pg8::bfhi; using pg8::row_rstd; using pg8::sigmoidf_;

constexpr int NWAVES = 8;
constexpr int BATCH = 8, SEQ = 2048, D = 1024, FF = 2816, M = BATCH * SEQ, NIN = 7176, DEPTH = 2;
constexpr float LOG2E = 1.4426950408889634f;
constexpr float C2 = 0.125f * LOG2E;
constexpr size_t MiB = 1u << 20;
constexpr size_t WS_CTL = 0;
constexpr size_t WS_W1 = 1 * MiB;
constexpr size_t WS_W2 = WS_W1 + 11 * MiB;
constexpr size_t WS_W3 = WS_W2 + 11 * MiB / 2;
constexpr size_t WS_W4 = WS_W3 + 11 * MiB;
constexpr size_t WS_WIN = WS_W4 + 11 * MiB / 2;
constexpr size_t WS_WBR = WS_WIN + 14 * MiB;
constexpr size_t WS_WO = WS_WBR + 3 * MiB;
constexpr size_t WS_WQKV = WS_WO + 2 * MiB;
constexpr size_t WS_UVF = WS_WQKV + 384 * 1024;
constexpr size_t WS_WFFT = WS_UVF + 32 * 1024;
constexpr size_t WS_RS = WS_WFFT + 64 * 1024;
constexpr size_t WS_FFB = WS_RS + 1 * MiB;
constexpr size_t WS_LIFP = WS_FFB + MiB / 2;
constexpr size_t WS_LIF = WS_LIFP, WS_CS = WS_LIFP + 512 * 1024, WS_MP = WS_CS + 4096, WS_NV = WS_LIFP + 768 * 1024, WS_NP = WS_LIFP + 1024 * 1024;
constexpr size_t WS_XB = 58 * MiB;
constexpr size_t WS_SLOT = 90 * MiB;
constexpr size_t SLOT_BYTES = SLOT_STRIDE_E * 2, SLOT_ELEMS = SLOT_STRIDE_E;
constexpr size_t WS_END = WS_SLOT + 11 * SLOT_BYTES;
static_assert(WS_LIFP + 2 * MiB <= WS_XB, "ws map");
enum { S_DQ = 0, S_FQ = 1, S_DK = 2, S_MX = 3, S_MZ = 4, S_DV = 5, S_FK = 6, S_FV = 7, S_A1 = 8, S_A2 = 9, S_MQ = 5, S_MK = 6, S_MV = 2, S_CP = 8, S_G0 = 5, S_MG = 3 };
constexpr int XB_LDS_OFF = 155648 - 64;
constexpr int RING_BYTES = 131072, LDS_BYTES = 155648;

#define LDS_WAIT() asm volatile("s_waitcnt lgkmcnt(0)" ::: "memory")
#define VM_WAIT() asm volatile("s_waitcnt vmcnt(0)" ::: "memory")
__device__ __forceinline__ float wave_sum(float v) {
#pragma unroll
    for (int o = 1; o < 64; o <<= 1) v += __shfl_xor(v, o);
    return v;
}
__device__ __forceinline__ float log_sigmoid_f(float x) { return fminf(x, 0.f) - __logf(1.0f + __expf(-fabsf(x))); }
__device__ __forceinline__ float silu_f(float x) { return x * __builtin_amdgcn_rcpf(1.0f + __expf(-x)); }

struct Frame {
    LAS unsigned char* lds; char* ldsg;
    int tid, wave, vcu, G, vbx;
    const float* const* in;
};

template <bool SCALED>
__device__ __forceinline__ void tr_item(const float* src, int ldsrc, int scol0, const float* scale, bf16* dst, int Kd, int drow0, int k0, LAS float* scr, int lane) {
    float v[32], sc[32];
#pragma unroll
    for (int i = 0; i < 32; ++i) { const int kk = 2 * i + (lane >> 5); v[i] = src[(size_t)(k0 + kk) * ldsrc + scol0 + (lane & 31)]; sc[i] = SCALED ? scale[k0 + kk] : 1.0f; }
#pragma unroll
    for (int i = 0; i < 32; ++i) { const int kk = 2 * i + (lane >> 5); scr[kk * 33 + (lane & 31)] = SCALED ? v[i] * sc[i] : v[i]; }
    LDS_WAIT(); asm volatile("" ::: "memory");
    const int c = lane & 7;
#pragma unroll
    for (int j = 0; j < 4; ++j) { const int n = (lane >> 3) + 8 * j; const LAS float* s = scr + (8 * c) * 33 + n;
        v4u o; o.x = pkbf(s[0 * 33], s[1 * 33]); o.y = pkbf(s[2 * 33], s[3 * 33]); o.z = pkbf(s[4 * 33], s[5 * 33]); o.w = pkbf(s[6 * 33], s[7 * 33]);
        *(v4u*)(dst + (size_t)(drow0 + n) * Kd + k0 + 8 * c) = o; }
    LDS_WAIT(); asm volatile("" ::: "memory");
}
struct Args { const float* in[32]; float* out; unsigned char* ws; int ph_lo, ph_hi; };
typedef __attribute__((address_space(4))) const Args* KArgs;
__device__ __forceinline__ bf16* slotp(unsigned char* ws, int s) { return (bf16*)(ws + WS_SLOT + (size_t)s * SLOT_BYTES); }
__device__ __forceinline__ f32x4 mfma16(bf16x8 a, bf16x8 b, f32x4 c) { return __builtin_amdgcn_mfma_f32_16x16x32_bf16(a, b, c, 0, 0, 0); }
__device__ __forceinline__ v4i16 trd(const LAS bf16* p) { return __builtin_amdgcn_ds_read_tr16_b64_v4i16((LAS v4i16*)p); }
__device__ __forceinline__ bf16x8 tr2(const LAS bf16* base, int r0, int c0, int stride, int lane) {
    const int i = lane & 15, q = i >> 2, p = i & 3; const LAS bf16* a = base + (r0 + q) * stride + c0 + 4 * p;
    const v4i16 lo = trd(a), hi = trd(a + 4 * stride);
    return (bf16x8){lo[0], lo[1], lo[2], lo[3], hi[0], hi[1], hi[2], hi[3]};
}
__device__ __forceinline__ void unpack8(const v4u w, float* x) { x[0] = bflo(w.x); x[1] = bfhi(w.x); x[2] = bflo(w.y); x[3] = bfhi(w.y); x[4] = bflo(w.z); x[5] = bfhi(w.z); x[6] = bflo(w.w); x[7] = bfhi(w.w); }
__device__ __forceinline__ v4u pack8(const float* x) { v4u o; o.x = pkbf(x[0], x[1]); o.y = pkbf(x[2], x[3]); o.z = pkbf(x[4], x[5]); o.w = pkbf(x[6], x[7]); return o; }

__device__ __forceinline__ void phase_prep(Frame& F, KArgs a, int l, int groups, int gw, int NGW) {
    unsigned char* ws = a->ws;
    LAS float* scr = (LAS float*)(F.lds + F.wave * 16384);
    const int lane = (F.tid & 63);
    bf16* W1 = (bf16*)(ws + WS_W1); bf16* W2 = (bf16*)(ws + WS_W2); bf16* W3 = (bf16*)(ws + WS_W3); bf16* W4 = (bf16*)(ws + WS_W4);
    bf16* WIN = (bf16*)(ws + WS_WIN); bf16* WBR = (bf16*)(ws + WS_WBR); bf16* WO = (bf16*)(ws + WS_WO); bf16* WQKV = (bf16*)(ws + WS_WQKV);
    constexpr int I_UP = 16 * 176, I_DN = 44 * 32, I_IN = 16 * 224, I_BR = 3 * 8 * 32, I_O = 16 * 32, I_QKV = 12 * 8;
    constexpr int NITEMS = 2 * I_UP + 2 * I_DN + I_IN + I_BR + I_O + I_QKV;
    for (int it = gw; it < NITEMS; it += NGW) {
        int r = it;
        if (r < 2 * (I_UP + I_DN)) {
            const int f2 = r >= (I_UP + I_DN); if (f2) r -= (I_UP + I_DN);
            if (!(groups & (f2 ? 2 : (r < I_UP ? 1 : 16)))) continue;
            const float* nrm = a->in[f2 ? 27 : 1] + (size_t)l * D; const float* wg = a->in[f2 ? 28 : 2] + (size_t)l * D * FF; const float* wu = a->in[f2 ? 29 : 3] + (size_t)l * D * FF; const float* wd = a->in[f2 ? 30 : 4] + (size_t)l * D * FF;
            if (r < I_UP) { const int kb = r / 176, nb = r % 176, n0 = 32 * nb, pn = n0 >> 8, j = n0 & 255;
                tr_item<true>(j < 128 ? wg : wu, FF, 128 * pn + (j & 127), nrm, f2 ? W3 : W1, D, n0, 64 * kb, scr, lane); }
            else { r -= I_UP; const int kb = r / 32, nb = r % 32; tr_item<false>(wd, D, 32 * nb, nullptr, f2 ? W4 : W2, FF, 32 * nb, 64 * kb, scr, lane); }
            continue; }
        r -= 2 * (I_UP + I_DN);
        if (!(groups & 4)) continue;
        if (r < I_IN) { const int kb = r / 224, nb = r % 224, n0 = 32 * nb; tr_item<true>(a->in[6] + (size_t)l * D * NIN, NIN, n0 < 3072 ? n0 : n0 + 8, a->in[5] + (size_t)l * D, WIN, D, n0, 64 * kb, scr, lane); continue; }
        r -= I_IN;
        if (r < I_BR) { const int z = r / 256, rr = r % 256, kb = rr / 32, nb = rr % 32;
            const float* src = (z == 0 ? a->in[23] : (z == 1 ? a->in[24] : a->in[25])) + (size_t)l * 512 * D;
            tr_item<false>(src, D, 32 * nb, nullptr, WBR + (size_t)z * D * 512, 512, 32 * nb, 64 * kb, scr, lane); continue; }
        r -= I_BR;
        if (r < I_O) { const int kb = r / 32, nb = r % 32; tr_item<false>(a->in[26] + (size_t)l * D * D, D, 32 * nb, nullptr, WO, D, 32 * nb, 64 * kb, scr, lane); continue; }
        r -= I_O;
        { const int mh = r >> 3, rr = r & 7, mt = mh >> 2, hh = mh & 3, kb = rr >> 2, nb = rr & 3;
          const float* src = (mt == 0 ? a->in[16] : (mt == 1 ? a->in[17] : a->in[18])) + (size_t)(l * 4 + hh) * 128 * 128;
          tr_item<false>(src, 128, 32 * nb, nullptr, WQKV + (size_t)mh * 16384, 128, 32 * nb, 64 * kb, scr, lane); }
    }
    if (groups & 4) { float* UVF = (float*)(ws + WS_UVF); const float* wq = a->in[16] + (size_t)l * 4 * 16384; const float* wk = a->in[17] + (size_t)l * 4 * 16384; const float* wv = a->in[18] + (size_t)l * 4 * 16384; const float* wif = a->in[19] + (size_t)l * 1536 * 8;
      for (int it = gw; it < 512; it += NGW) { const int hh = it >> 7, d = it & 127;
          const float* q = wq + (size_t)(hh * 128 + d) * 128; const float* k = wk + (size_t)(hh * 128 + d) * 128; const float* v = wv + (size_t)(hh * 128 + d) * 128;
          float U[8], V[8];
#pragma unroll
          for (int g = 0; g < 8; ++g) { U[g] = 0.f; V[g] = 0.f; }
#pragma unroll
          for (int eh = 0; eh < 2; ++eh) { const int e = lane + 64 * eh; const float qe = q[e], ke = k[e], ve = v[e];
              const f32x4* wqp = (const f32x4*)(wif + (size_t)(hh * 128 + e) * 8); const f32x4* wkp = (const f32x4*)(wif + (size_t)(512 + hh * 128 + e) * 8); const f32x4* wvp = (const f32x4*)(wif + (size_t)(1024 + hh * 128 + e) * 8);
#pragma unroll
              for (int c4 = 0; c4 < 2; ++c4) { const f32x4 a4 = wqp[c4], b4 = wkp[c4], c4v = wvp[c4];
#pragma unroll
                  for (int i = 0; i < 4; ++i) { U[4 * c4 + i] += qe * a4[i] + ke * b4[i]; V[4 * c4 + i] += ve * c4v[i]; } } }
#pragma unroll
          for (int g = 0; g < 8; ++g) { const float us = wave_sum(U[g]), vs = wave_sum(V[g]);
              if (lane == 0) { UVF[(size_t)((g & 3) * 4 + (g >> 2)) * 512 + hh * 128 + d] = us; UVF[(size_t)((g & 3) * 4 + 2 + (g >> 2)) * 512 + hh * 128 + d] = vs; } } }
      bf16* WFFT = (bf16*)(ws + WS_WFFT); const float* win = a->in[6] + (size_t)l * D * NIN; const float* nrm = a->in[5] + (size_t)l * D;
      for (int i = gw * 64 + lane; i < 8192; i += NGW * 64) { const int k = i >> 3, g = i & 7; const float w = nrm[k] * win[(size_t)k * NIN + 3072 + g];
          const unsigned wh = pkbf(w, 0.f) & 0xffffu, wl = pkbf(w - bflo(wh), 0.f) & 0xffffu; WFFT[g * 1024 + k] = (bf16)wh; WFFT[(8 + g) * 1024 + k] = (bf16)wl; }
    }
    if (groups & 8) {
        const float* x = a->in[0]; bf16* XB = (bf16*)(ws + WS_XB); float* RS = (float*)(ws + WS_RS);
        for (int m = gw; m < M; m += NGW) { const f32x4* xr = (const f32x4*)(x + (size_t)m * D) + lane; float s = 0.f; v2u* o8 = (v2u*)(XB + (size_t)m * D) + lane;
#pragma unroll
            for (int j = 0; j < 4; ++j) { const f32x4 v = xr[64 * j]; s += (v[0] * v[0] + v[1] * v[1]) + (v[2] * v[2] + v[3] * v[3]); v2u w; w.x = pkbf(v[0], v[1]); w.y = pkbf(v[2], v[3]); o8[64 * j] = w; }
            s = wave_sum(s);
            if (lane < 16) RS[(size_t)m * 16 + lane] = (lane == 0) ? s : 0.f; }
    }
}

__device__ __forceinline__ void job_ff(Frame& F, unsigned char* ws) {
    const bf16* WFFT = (const bf16*)(ws + WS_WFFT); const bf16* XB = (const bf16*)(ws + WS_XB); const float* RS = (const float*)(ws + WS_RS); float* FFB = (float*)(ws + WS_FFB);
    const int gw = F.vcu * NWAVES + F.wave, NGW = F.G * NWAVES, lane = (F.tid & 63), g = lane >> 4, li = lane & 15;
    for (int blk = (F.wave < 4 ? (F.vcu >> 5) * 128 + ((F.vcu & 31) & 7) * 16 + ((F.vcu & 31) >> 3) * 4 + F.wave : M / 16); blk < M / 16; blk += M / 16) {     const int r0 = 16 * blk;     f32x4 acc = {0.f, 0.f, 0.f, 0.f};
        const bf16* ap = XB + (size_t)(r0 + li) * D + 8 * g; const bf16* bp = WFFT + (size_t)li * D + 8 * g;
#pragma unroll
        for (int hf = 0; hf < 2; ++hf) { bf16x8 A[16], B[16];
#pragma unroll
            for (int ks = 0; ks < 16; ++ks) { A[ks] = *(const bf16x8*)(ap + 32 * (16 * hf + ks)); B[ks] = *(const bf16x8*)(bp + 32 * (16 * hf + ks)); }
#pragma unroll
            for (int ks = 0; ks < 16; ++ks) acc = mfma16(A[ks], B[ks], acc); }
#pragma unroll
        for (int r = 0; r < 4; ++r) { const float v = acc[r] + __shfl_xor(acc[r], 8); const int row = r0 + 4 * g + r; if ((lane & 8) == 0) FFB[(size_t)row * 8 + (lane & 7)] = v * row_rstd(RS, row); } }
}

__device__ __forceinline__ void phase_attn(Frame& F, KArgs a, int l, bool diff_only) {
    unsigned char* ws = a->ws; char* lds = F.ldsg;
    const float* FFB = (const float*)(ws + WS_FFB);
    for (int p = F.vcu; p < 512; p += F.G) {
        int tid = F.tid; asm volatile("" : "+v"(tid)); const int lane = tid & 63;
        int wave = F.wave; asm volatile("" : "+s"(wave));
        const bool diff = p < 256; if (diff_only && !diff) continue;
        const int idx = p & 255, bvh = idx >> 2, s = idx & 3, b = bvh >> 3, vh = bvh & 7; const size_t rowoff = (size_t)b * SEQ * 512;
        if (diff) { const int h = vh >> 1, mp = vh & 1; float* table = (float*)(lds + attn::LDS2_BIAS);
            const bf16* Q = slotp(ws, S_DQ) + rowoff + h * 128 + mp * 64; const bf16* K = slotp(ws, S_DK) + rowoff + h * 128 + mp * 64; const bf16* V = slotp(ws, S_DV) + rowoff + h * 128; bf16* O = slotp(ws, mp ? S_A2 : S_A1) + rowoff + h * 128;
            const float sl = exp2f(-2.0f * (float)(h + 1)) * LOG2E;
#pragma unroll
            for (int i = 0; i < 4; ++i) table[4 * tid + i] = sl * (float)(4 * tid + i);
            asm volatile("s_waitcnt lgkmcnt(0)\n\ts_barrier" ::: "memory");
#pragma unroll 1
            for (int rep = 0; rep < 2; ++rep) attn::attn_unit2(Q, K, V, O, rep ? 7 - s : s, 0, lds);
        } else { const int h = vh; float* table = (float*)(lds + attn::LDS_BIAS); float* wsum = (float*)(lds + attn::LDS_WS);
            const bf16* Q = slotp(ws, S_FQ) + rowoff + h * 64; const bf16* K = slotp(ws, S_FK) + rowoff + h * 64; const bf16* V = slotp(ws, S_FV) + rowoff + h * 64; bf16* O = slotp(ws, S_FQ) + rowoff + h * 64;
            const float bf = a->in[13][l * 8 + h]; float c[4]; float run = 0.f;
#pragma unroll
            for (int i = 0; i < 4; ++i) { run += log_sigmoid_f(FFB[((size_t)b * SEQ + 4 * tid + i) * 8 + h] + bf); c[i] = run; }
            float v = run;
#pragma unroll
            for (int o = 1; o < 64; o <<= 1) { const float t = __int_as_float(__builtin_amdgcn_ds_bpermute(((lane >= o) ? lane - o : lane) << 2, __float_as_int(v))); if (lane >= o) v += t; }
            if (lane == 63) wsum[wave] = v;
            asm volatile("s_waitcnt lgkmcnt(0)\n\ts_barrier" ::: "memory");
            float base = v - run;
#pragma unroll
            for (int w = 0; w < 8; ++w) if (w < wave) base += wsum[w];
#pragma unroll
            for (int i = 0; i < 4; ++i) table[4 * tid + i] = -(base + c[i]) * LOG2E;
            asm volatile("s_waitcnt lgkmcnt(0)\n\ts_barrier" ::: "memory");
#pragma unroll 1
            for (int rep = 0; rep < 2; ++rep) attn::attn_unit(Q, K, V, O, rep ? 7 - s : s, 0, lds);
        }
    }
}
__device__ __forceinline__ void job_diff_combine(Frame& F, KArgs a, int l) {
    unsigned char* ws = a->ws; const int gw = F.vcu * NWAVES + F.wave, NGW = F.G * NWAVES, lane = (F.tid & 63);
    const bf16* A1 = slotp(ws, S_A1); const bf16* A2 = slotp(ws, S_A2); bf16* OD = slotp(ws, S_DQ);
    const float lam_init = 0.8f - 0.6f * expf(-0.3f * (float)l);
    const float s1 = wave_sum(a->in[8][l * 64 + lane] * a->in[9][l * 64 + lane]), s2 = wave_sum(a->in[10][l * 64 + lane] * a->in[11][l * 64 + lane]);
    const float lam = expf(s1) - expf(s2) + lam_init, osc = 1.0f - lam_init;
    float sw[8];
#pragma unroll
    for (int i = 0; i < 8; ++i) sw[i] = a->in[12][l * 128 + ((8 * lane) & 127) + i] * osc;
    for (int m = (F.vcu >> 5) * SEQ + (F.vcu & 31) * NWAVES + F.wave, me = ((F.vcu >> 5) + 1) * SEQ; m < me; m += 32 * NWAVES) {
        const v4u w1 = *((const v4u*)(A1 + (size_t)m * 512) + lane), w2 = *((const v4u*)(A2 + (size_t)m * 512) + lane);
        float x1[8], x2[8], d[8]; unpack8(w1, x1); unpack8(w2, x2); float ss = 0.f;
#pragma unroll
        for (int i = 0; i < 8; ++i) { d[i] = x1[i] - lam * x2[i]; ss += d[i] * d[i]; }
        ss += __shfl_xor(ss, 1); ss += __shfl_xor(ss, 2); ss += __shfl_xor(ss, 4); ss += __shfl_xor(ss, 8);
        const float rstd = 1.0f / sqrtf(ss * (1.0f / 128.0f) + 1e-6f);
#pragma unroll
        for (int i = 0; i < 8; ++i) d[i] = d[i] * rstd * sw[i];
        *((v4u*)(OD + (size_t)m * 512) + lane) = pack8(d);
    }
}

#define LBAR() asm volatile("s_waitcnt lgkmcnt(0)\n\ts_barrier" ::: "memory")
constexpr int TS = 136;
__device__ __forceinline__ bf16* kv_ptr(unsigned char* ws, int u) { return slotp(ws, 7) + (size_t)u * 16384; }
__device__ __forceinline__ void conv_block(const bf16* MX, const float* cw, const float* cb, int r0, int pos0, int c0, int t0, float (&xc)[4][8], float (&xm)[4][8]) {
    float x[7][8];
#pragma unroll
    for (int k = 0; k < 7; ++k) { const int t = t0 - 3 + k; const bool ok = (pos0 + t >= 0); v4u raw = *(const v4u*)(MX + (size_t)(r0 + (ok ? t : 0)) * 512 + c0);
        if (!ok) raw = (v4u){0u, 0u, 0u, 0u}; unpack8(raw, x[k]); }
#pragma unroll
    for (int i = 0; i < 8; ++i) { const float b = cb[c0 + i], w0 = cw[c0 + i], w1 = cw[512 + c0 + i], w2 = cw[1024 + c0 + i], w3 = cw[1536 + c0 + i];
#pragma unroll
        for (int tt = 0; tt < 4; ++tt) { xc[tt][i] = silu_f(b + w0 * x[tt][i] + w1 * x[tt + 1][i] + w2 * x[tt + 2][i] + w3 * x[tt + 3][i]); xm[tt][i] = x[tt + 3][i]; } }
}
__device__ __forceinline__ void job_gates(Frame& F, KArgs a, int l) {
    unsigned char* ws = a->ws; const int tid = F.tid, lane = tid & 63, w = F.wave, li = lane & 15, g = lane >> 4;
    const bf16* MX = slotp(ws, S_MX); const float* UVF = (const float*)(ws + WS_UVF); float* LIF = (float*)(ws + WS_LIF);
    const float* cw = a->in[14] + (size_t)l * 4 * 512; const float* cb = a->in[15] + (size_t)l * 512;
    const int R0 = (F.vcu >> 5) * SEQ + (F.vcu & 31) * 64;
    LAS float* part = (LAS float*)F.lds;
    bf16x8 BU[2], BV[2];
    { const int gt = li & 7, ru = (gt & 3) * 4 + (gt >> 2);
#pragma unroll
      for (int ks = 0; ks < 2; ++ks) { const float* pu = UVF + (size_t)ru * 512 + 64 * w + 32 * ks + 8 * g; const float* pv = pu + 1024;
          const f32x4 u0 = *(const f32x4*)pu, u1 = *(const f32x4*)(pu + 4), v0 = *(const f32x4*)pv, v1 = *(const f32x4*)(pv + 4);
          float uu[8] = {u0[0], u0[1], u0[2], u0[3], u1[0], u1[1], u1[2], u1[3]}, vv[8] = {v0[0], v0[1], v0[2], v0[3], v1[0], v1[1], v1[2], v1[3]};
          if (li >= 8) {
#pragma unroll
              for (int i = 0; i < 8; ++i) { uu[i] -= bflo(pkbf(uu[i], 0.f)); vv[i] -= bflo(pkbf(vv[i], 0.f)); } }
          BU[ks] = __builtin_bit_cast(bf16x8, pack8(uu)); BV[ks] = __builtin_bit_cast(bf16x8, pack8(vv)); } }
    float wj[2][4][8], bb[2][8];
#pragma unroll
    for (int ks = 0; ks < 2; ++ks) { const int c0 = 64 * w + 32 * ks + 8 * g;
#pragma unroll
        for (int i = 0; i < 8; ++i) { bb[ks][i] = cb[c0 + i];
#pragma unroll
            for (int j = 0; j < 4; ++j) wj[ks][j][i] = cw[j * 512 + c0 + i]; } }
#pragma unroll 1
    for (int T = 0; T < 4; ++T) { const int m = R0 + 16 * T + li, pos = m & (SEQ - 1); f32x4 acc = {0.f, 0.f, 0.f, 0.f};
        v4u raw[2][4];
#pragma unroll
        for (int ks = 0; ks < 2; ++ks)
#pragma unroll
            for (int j = 0; j < 4; ++j) { const bool ok = (pos - 3 + j >= 0); raw[ks][j] = *(const v4u*)(MX + (size_t)(m - (ok ? 3 - j : 0)) * 512 + 64 * w + 32 * ks + 8 * g); if (!ok) raw[ks][j] = (v4u){0u, 0u, 0u, 0u}; }
#pragma unroll
        for (int ks = 0; ks < 2; ++ks) { float x[4][8], xc[8];
#pragma unroll
            for (int j = 0; j < 4; ++j) unpack8(raw[ks][j], x[j]);
#pragma unroll
            for (int i = 0; i < 8; ++i) xc[i] = silu_f(bb[ks][i] + wj[ks][0][i] * x[0][i] + wj[ks][1][i] * x[1][i] + wj[ks][2][i] * x[2][i] + wj[ks][3][i] * x[3][i]);
            acc = mfma16(__builtin_bit_cast(bf16x8, pack8(xc)), BU[ks], acc); acc = mfma16(__builtin_bit_cast(bf16x8, raw[ks][3]), BV[ks], acc); }
#pragma unroll
        for (int r = 0; r < 4; ++r) { const float v = acc[r] + __shfl_xor(acc[r], 8); if ((lane & 8) == 0) part[((w * 4 + T) * 16 + 4 * g + r) * 8 + (lane & 7)] = v; } }
    __syncthreads();
    { const int row = tid >> 3, gt = tid & 7; float s = a->in[20][l * 8 + gt];
#pragma unroll
      for (int ww = 0; ww < 8; ++ww) s += part[((ww * 4 + (row >> 4)) * 16 + (row & 15)) * 8 + gt];
      LIF[((size_t)(R0 + row) * 4 + (gt & 3)) * 2 + (gt >> 2)] = (gt < 4) ? s : log_sigmoid_f(s); }
    __syncthreads();
}
__device__ __forceinline__ void mA_unit(Frame& F, KArgs a, int l, int u) {
    unsigned char* ws = a->ws; const int tid = F.tid, lane = (F.tid & 63), w = F.wave, g = lane >> 4, li = lane & 15; const int h = u & 3, rb = u >> 2;
    LAS bf16* XC = (LAS bf16*)F.lds; LAS bf16* MH = (LAS bf16*)(F.lds + 36864); LAS bf16* QT = MH; LAS bf16* VW = (LAS bf16*)F.lds; LAS bf16* KT = (LAS bf16*)(F.lds + 71680); LAS bf16* VX = (LAS bf16*)(F.lds + 106496);
    LAS float* vli = (LAS float*)(F.lds + 143360); LAS float* vlf = vli + 128; LAS float* vwk = vli + 256;
    const bf16* MX = slotp(ws, S_MX); const int r0 = rb * 128, pos0 = r0 & (SEQ - 1);
    { const int ch = tid & 15, rg = tid >> 4, t0 = 4 * rg; float xc[4][8], xm[4][8];
      conv_block(MX, a->in[14] + (size_t)l * 4 * 512, a->in[15] + (size_t)l * 512, r0, pos0, h * 128 + ch * 8, t0, xc, xm);
#pragma unroll
      for (int tt = 0; tt < 4; ++tt) { *(LAS v4u*)(XC + (t0 + tt) * TS + ch * 8) = pack8(xc[tt]); *(LAS v4u*)(MH + (t0 + tt) * TS + ch * 8) = pack8(xm[tt]); }
    }
    LBAR();
    if (w == 0) { const float* LIF = (const float*)(ws + WS_LIF);
        const v2u p0 = *(const v2u*)(LIF + ((size_t)(r0 + 2 * lane) * 4 + h) * 2), p1 = *(const v2u*)(LIF + ((size_t)(r0 + 2 * lane + 1) * 4 + h) * 2);
        const float l0 = __uint_as_float(p0.x), f0 = __uint_as_float(p0.y), l1 = __uint_as_float(p1.x), f1 = __uint_as_float(p1.y);
        float incl = f0 + f1;
#pragma unroll
        for (int o = 1; o < 64; o <<= 1) { const float t = __shfl_up(incl, o); if (lane >= o) incl += t; }
        const float b1 = incl, b0 = incl - f1, a0 = l0 - b0, a1 = l1 - b1; float am = fmaxf(a0, a1);
#pragma unroll
        for (int o = 1; o < 64; o <<= 1) am = fmaxf(am, __shfl_xor(am, o));
        const float blast = __shfl(incl, 63);
        vwk[2 * lane] = expf(a0 - am); vwk[2 * lane + 1] = expf(a1 - am);
        if (lane == 0) { float* CS = (float*)(ws + WS_CS); CS[2 * u] = blast; CS[2 * u + 1] = blast + am; } }
    { const int row = tid >> 2, q4 = tid & 3; unsigned z_ = 0u; asm volatile("" : "+v"(z_));
      if (q4 == 0) { *(LAS v4u*)(VX + row * 144 + 128) = (v4u){0x00003F80u | z_, z_, z_, z_}; *(LAS v4u*)(VX + row * 144 + 136) = (v4u){z_, z_, z_, z_}; } }
    const bf16* WQKV = (const bf16*)(ws + WS_WQKV);
    bf16x8 Afa[3][4];
#pragma unroll
    for (int mt = 0; mt < 3; ++mt)
#pragma unroll
        for (int ks = 0; ks < 4; ++ks) Afa[mt][ks] = *(const bf16x8*)(WQKV + ((size_t)(mt * 4 + h) * 128 + 16 * w + li) * 128 + 32 * ks + 8 * g);
#pragma unroll
    for (int pass = 0; pass < 3; ++pass) { const int mt = (pass == 0) ? 2 : pass - 1;
        bf16x8 Af[4];
#pragma unroll
        for (int ks = 0; ks < 4; ++ks) Af[ks] = Afa[mt][ks];
        const LAS bf16* src = (mt == 2) ? MH : XC; const float sc = (mt == 1) ? 0.08838834764831845f : 1.0f;
#pragma unroll 2
        for (int tb = 0; tb < 8; ++tb) { f32x4 acc = {0.f, 0.f, 0.f, 0.f};
#pragma unroll
            for (int ks = 0; ks < 4; ++ks) { const bf16x8 B = *(const LAS bf16x8*)(src + (16 * tb + li) * TS + 32 * ks + 8 * g); acc = mfma16(Af[ks], B, acc); }
            v2u o; o.x = pkbf(acc[0] * sc, acc[1] * sc); o.y = pkbf(acc[2] * sc, acc[3] * sc);
            if (mt == 0) *(LAS v2u*)(QT + (16 * tb + li) * TS + 16 * w + 4 * g) = o;
            if (mt == 1) *(LAS v2u*)(KT + (16 * tb + li) * TS + 16 * w + 4 * g) = o;
            if (mt == 2) *(LAS v2u*)(VX + (16 * tb + li) * 144 + 16 * w + 4 * g) = o; }
        if (pass == 0) LBAR();
    }
    LBAR();
#pragma unroll
    for (int i = 0; i < 4; ++i) { const int idx = tid + 512 * i, row = idx >> 4, ch = idx & 15; const size_t go = (size_t)(r0 + row) * 512 + h * 128 + ch * 8;
        *(v4u*)(slotp(ws, S_MQ) + go) = *(const LAS v4u*)(QT + row * TS + ch * 8); *(v4u*)(slotp(ws, S_MK) + go) = *(const LAS v4u*)(KT + row * TS + ch * 8); *(v4u*)(slotp(ws, S_MV) + go) = *(const LAS v4u*)(VX + row * 144 + ch * 8); }
    { const int s = tid >> 2, q4 = tid & 3; const float wk = vwk[s];
#pragma unroll
      for (int k = 0; k < 9; ++k) { const v2u xw = *(const LAS v2u*)(VX + s * 144 + q4 * 36 + 4 * k); v2u o; o.x = pkbf(bflo(xw.x) * wk, bfhi(xw.x) * wk); o.y = pkbf(bflo(xw.y) * wk, bfhi(xw.y) * wk); *(LAS v2u*)(VW + s * 144 + q4 * 36 + 4 * k) = o; } }
    LBAR();
    { f32x4 acc[9];
#pragma unroll
      for (int nt = 0; nt < 9; ++nt) acc[nt] = (f32x4){0.f, 0.f, 0.f, 0.f};
#pragma unroll
      for (int ks = 0; ks < 4; ++ks) { const bf16x8 Bk = tr2(KT, 32 * ks + 8 * g, 16 * w, TS, lane);
#pragma unroll
          for (int nt = 0; nt < 9; ++nt) acc[nt] = mfma16(tr2(VW, 32 * ks + 8 * g, 16 * nt, 144, lane), Bk, acc[nt]); }
      bf16* KV = kv_ptr(ws, u); float* NV = (float*)(ws + WS_NV) + (size_t)u * 128;
#pragma unroll
      for (int nt = 0; nt < 8; ++nt) { v2u o; o.x = pkbf(acc[nt][0], acc[nt][1]); o.y = pkbf(acc[nt][2], acc[nt][3]); *(v2u*)(KV + (size_t)(16 * w + li) * 128 + 16 * nt + 4 * g) = o; }
      if (g == 0) NV[16 * w + li] = acc[8][0];
    }
    LBAR();
}

__device__ __forceinline__ void job_scan(Frame& F, KArgs a) {
    unsigned char* ws = a->ws; const float* CS = (const float*)(ws + WS_CS); float* MP = (float*)(ws + WS_MP); const float* NV = (const float*)(ws + WS_NV); float* NP = (float*)(ws + WS_NP); bf16* CP = slotp(ws, S_CP);
    const int tl = (F.vcu & 31) * (NWAVES * 64) + F.tid, b = F.vcu >> 5, h = tl >> 12, e = tl & 4095; const bool hasn = e < 128;
    float z_ = 0.f; asm volatile("" : "+v"(z_));
    float m = 0.f; f32x4 C = {z_, z_, z_, z_}; float nn = z_;
#pragma unroll
    for (int c = 0; c < 16; ++c) { const int u = (b * 16 + c) * 4 + h; const float blast = CS[2 * u], mloc = CS[2 * u + 1];
        const float mnew = fmaxf(blast + m, mloc), dec = __expf(blast + m - mnew), sc = __expf(mloc - mnew);
        { v2u o; o.x = pkbf(C[0], C[1]); o.y = pkbf(C[2], C[3]); *(v2u*)(CP + (size_t)u * 16384 + 4 * e) = o; const v2u kw = *(const v2u*)(kv_ptr(ws, u) + 4 * e); const f32x4 kv = {bflo(kw.x), bfhi(kw.x), bflo(kw.y), bfhi(kw.y)}; C = C * dec + kv * sc; if (e == 0) MP[u] = m; }
        if (hasn) { NP[(size_t)u * 128 + e] = nn; nn = nn * dec + NV[(size_t)u * 128 + e] * sc; }
        m = mnew; }
}

__device__ __forceinline__ void mC_unit(Frame& F, KArgs a, int l, int u, int out_slot) {
    unsigned char* ws = a->ws; const int tid = F.tid, lane = (F.tid & 63), w = F.wave, g = lane >> 4, li = lane & 15; const int h = u & 3, rb = u >> 2;
    LAS bf16* QS = (LAS bf16*)F.lds; LAS bf16* KT = (LAS bf16*)(F.lds + 34816); LAS bf16* VX = (LAS bf16*)(F.lds + 69632); LAS bf16* CL = (LAS bf16*)(F.lds + 106496); LAS bf16* HT = KT;
    LAS float* va = (LAS float*)(F.lds + 143360); LAS float* vM = va + 128; LAS float* vwi = va + 256; LAS float* vemt = va + 384;
    const bf16* MQ = slotp(ws, S_MQ); const bf16* MK = slotp(ws, S_MK); bf16* MV = slotp(ws, S_MV); const bf16* CP = slotp(ws, S_CP) + (size_t)u * 16384; const float* NP = (const float*)(ws + WS_NP) + (size_t)u * 128;
    const size_t row0 = (size_t)rb * 128;
#pragma unroll
    for (int i = 0; i < 4; ++i) { const int idx = tid + 512 * i, row = idx >> 4, ch = idx & 15;
        *(LAS v4u*)(QS + row * TS + ch * 8) = *(const v4u*)(MQ + (row0 + row) * 512 + h * 128 + ch * 8);
        *(LAS v4u*)(KT + row * TS + ch * 8) = *(const v4u*)(MK + (row0 + row) * 512 + h * 128 + ch * 8);
        *(LAS v4u*)(VX + row * 144 + ch * 8) = *(const v4u*)(MV + (row0 + row) * 512 + h * 128 + ch * 8);
        *(LAS v4u*)(CL + row * 144 + ch * 8) = *(const v4u*)(CP + row * 128 + ch * 8); }
    { const int row = tid >> 2, q4 = tid & 3; unsigned z_ = 0u; asm volatile("" : "+v"(z_));
      if (q4 == 0) { *(LAS v4u*)(VX + row * 144 + 128) = (v4u){0x00003F80u | z_, z_, z_, z_}; *(LAS v4u*)(VX + row * 144 + 136) = (v4u){z_, z_, z_, z_}; }
      if (q4 == 1) { *(LAS v4u*)(CL + row * 144 + 128) = (v4u){pkbf(NP[row], 0.f), z_, z_, z_}; *(LAS v4u*)(CL + row * 144 + 136) = (v4u){z_, z_, z_, z_}; } }
    if (w == 0) { const float* LIF = (const float*)(ws + WS_LIF); const float mprev = ((const float*)(ws + WS_MP))[u];
        const v2u p0 = *(const v2u*)(LIF + ((row0 + 2 * lane) * 4 + h) * 2), p1 = *(const v2u*)(LIF + ((row0 + 2 * lane + 1) * 4 + h) * 2);
        const float l0 = __uint_as_float(p0.x), f0 = __uint_as_float(p0.y), l1 = __uint_as_float(p1.x), f1 = __uint_as_float(p1.y);
        float incl = f0 + f1;
#pragma unroll
        for (int o = 1; o < 64; o <<= 1) { const float t = __shfl_up(incl, o); if (lane >= o) incl += t; }
        const float b1 = incl, b0 = incl - f1, a0 = l0 - b0, a1 = l1 - b1; float inc = fmaxf(a0, a1);
#pragma unroll
        for (int o = 1; o < 64; o <<= 1) { const float t = __shfl_up(inc, o); if (lane >= o) inc = fmaxf(inc, t); }
        float exc = __shfl_up(inc, 1); if (lane == 0) exc = -INFINITY;
        const float M0 = fmaxf(mprev, fmaxf(exc, a0)), M1 = fmaxf(mprev, inc);
        va[2 * lane] = a0; va[2 * lane + 1] = a1; vM[2 * lane] = M0; vM[2 * lane + 1] = M1;
        vwi[2 * lane] = expf(mprev - M0); vwi[2 * lane + 1] = expf(mprev - M1); vemt[2 * lane] = expf(-(b0 + M0)); vemt[2 * lane + 1] = expf(-(b1 + M1)); }
    LBAR();
    bf16x8 qf[4];
#pragma unroll
    for (int ks = 0; ks < 4; ++ks) qf[ks] = *(const LAS bf16x8*)(QS + (16 * w + li) * TS + 32 * ks + 8 * g);
    LBAR();
    const int t = 16 * w + li; const float Mt = vM[t]; const int nst = (w | 1) + 1;
#pragma unroll 1
    for (int st = 0; st < nst; ++st) { f32x4 acc = {0.f, 0.f, 0.f, 0.f};
#pragma unroll
        for (int ks = 0; ks < 4; ++ks) { const bf16x8 A = *(const LAS bf16x8*)(KT + (16 * st + li) * TS + 32 * ks + 8 * g); acc = mfma16(A, qf[ks], acc); }
        const f32x4 a4 = *(const LAS f32x4*)(va + 16 * st + 4 * g); float sw[4];
#pragma unroll
        for (int r = 0; r < 4; ++r) { const int s = 16 * st + 4 * g + r; const float e = __expf(fminf(a4[r] - Mt, 0.f)); sw[r] = (s <= t) ? acc[r] * e : 0.f; }
        v2u o; o.x = pkbf(sw[0], sw[1]); o.y = pkbf(sw[2], sw[3]); *(LAS v2u*)(QS + t * TS + 16 * st + 4 * g) = o; }
    LBAR();
    { f32x4 accn[9], accq[9];
#pragma unroll
      for (int nt = 0; nt < 9; ++nt) { accn[nt] = (f32x4){0.f, 0.f, 0.f, 0.f}; accq[nt] = accn[nt]; }
      const int nks = (w >> 1) + 1;
#pragma unroll 1
      for (int ks = 0; ks < nks; ++ks) { const bf16x8 Bs = *(const LAS bf16x8*)(QS + t * TS + 32 * ks + 8 * g);
#pragma unroll
          for (int nt = 0; nt < 9; ++nt) accn[nt] = mfma16(tr2(VX, 32 * ks + 8 * g, 16 * nt, 144, lane), Bs, accn[nt]); }
#pragma unroll
      for (int ks = 0; ks < 4; ++ks)
#pragma unroll
          for (int nt = 0; nt < 9; ++nt) accq[nt] = mfma16(tr2(CL, 32 * ks + 8 * g, 16 * nt, 144, lane), qf[ks], accq[nt]);
      const float wi = vwi[t], em = vemt[t];
      const float den = wi * accq[8][0] + accn[8][0]; const float dn = __shfl(den, li); const float inv = 1.0f / fmaxf(fabsf(dn), em);
#pragma unroll
      for (int nt = 0; nt < 8; ++nt) { const f32x4 hv = (accq[nt] * wi + accn[nt]) * inv; v2u o; o.x = pkbf(hv[0], hv[1]); o.y = pkbf(hv[2], hv[3]); *(LAS v2u*)(HT + t * TS + 16 * nt + 4 * g) = o; }
    }
    LBAR();
    { const int ch = tid & 15, rg = tid >> 4, t0 = 4 * rg, c0 = h * 128 + ch * 8; const int r0 = rb * 128, pos0 = r0 & (SEQ - 1);
      float xc[4][8], xm[4][8]; conv_block(slotp(ws, S_MX), a->in[14] + (size_t)l * 4 * 512, a->in[15] + (size_t)l * 512, r0, pos0, c0, t0, xc, xm);
      const float* nw = a->in[21] + (size_t)l * 512 + c0; const float* sk = a->in[22] + (size_t)l * 512 + c0; const bf16* MZ = slotp(ws, S_MZ);
      float nn[8], ss[8];
#pragma unroll
      for (int i = 0; i < 8; ++i) { nn[i] = nw[i]; ss[i] = sk[i]; }
#pragma unroll
      for (int tt = 0; tt < 4; ++tt) { float hm[8], z[8]; unpack8(*(const LAS v4u*)(HT + (t0 + tt) * TS + ch * 8), hm); unpack8(*(const v4u*)(MZ + (size_t)(r0 + t0 + tt) * 512 + c0), z);
          float s = 0.f;
#pragma unroll
          for (int i = 0; i < 8; ++i) s += hm[i];
          s += __shfl_xor(s, 1); s += __shfl_xor(s, 2); s += __shfl_xor(s, 4); s += __shfl_xor(s, 8);
          const float mu = s * (1.0f / 128.0f); float q = 0.f;
#pragma unroll
          for (int i = 0; i < 8; ++i) { hm[i] -= mu; q += hm[i] * hm[i]; }
          q += __shfl_xor(q, 1); q += __shfl_xor(q, 2); q += __shfl_xor(q, 4); q += __shfl_xor(q, 8);
          const float rstd = 1.0f / sqrtf(q * (1.0f / 128.0f) + 1e-5f); float o[8];
#pragma unroll
          for (int i = 0; i < 8; ++i) o[i] = (hm[i] * rstd * nn[i] + ss[i] * xc[tt][i]) * silu_f(z[i]);
          *(v4u*)(slotp(ws, out_slot) + (size_t)(r0 + t0 + tt) * 512 + c0) = pack8(o); }
    }
    LBAR();
}

__device__ __forceinline__ void job_final_norm(Frame& F, KArgs a) {
    const int gw = F.vcu * NWAVES + F.wave, NGW = F.G * NWAVES, lane = (F.tid & 63); const float* RS = (const float*)(a->ws + WS_RS); const bf16* XB = (const bf16*)(a->ws + WS_XB); const f32x4* fw = (const f32x4*)a->in[31] + 2 * lane;
    f32x4 wv[4];
#pragma unroll
    for (int j = 0; j < 2; ++j) { wv[2 * j] = fw[128 * j]; wv[2 * j + 1] = fw[128 * j + 1]; }
    for (int m = gw; m < M; m += NGW) { const float rs = row_rstd(RS, m); const v4u* xr = (const v4u*)(XB + (size_t)m * D) + lane; f32x4* orow = (f32x4*)(a->out + (size_t)m * D) + 2 * lane;
#pragma unroll
        for (int j = 0; j < 2; ++j) { float x[8]; unpack8(xr[64 * j], x);
            orow[128 * j] = (f32x4){x[0], x[1], x[2], x[3]} * rs * wv[2 * j]; orow[128 * j + 1] = (f32x4){x[4], x[5], x[6], x[7]} * rs * wv[2 * j + 1]; } }
}
#define XB_TMO      128
#define XB_XCNT(j)  (256  + 64 * (j))
#define XB_XSUB(j)  (1280 + 64 * (j))
#define XB_XGEN(j)  (2304 + 64 * (j))
#define XB_TOP      3328
#define XB_TOPGEN   3392
#define XCD_BAR_WORDS 3456
#define XB_PSUB(j)  (4096 + 64 * (j))
#define XB_PGEN(j)  (8192 + 64 * (j))
#define XB_XPAN(j)  (12288 + 64 * (j))
#define XB_SPIN_CAP (1u << 18)

__device__ __forceinline__ unsigned xb_ld(unsigned* p)              { return __hip_atomic_load(p, __ATOMIC_RELAXED, __HIP_MEMORY_SCOPE_AGENT); }
__device__ __forceinline__ unsigned xb_add(unsigned* p, unsigned v) { return __hip_atomic_fetch_add(p, v, __ATOMIC_RELAXED, __HIP_MEMORY_SCOPE_AGENT); }
__device__ __forceinline__ unsigned xb_xcc_id() { return (unsigned)__builtin_amdgcn_s_getreg((3 << 11) | 20) & 0xFu; }
#define XB_SPIN(cond, bar) do { unsigned _sp = 0; while (cond) { __builtin_amdgcn_s_sleep(1); \
    if ((++_sp & 255u) == 0u) { if (xb_ld(&(bar)[XB_TMO])) break; if (_sp > XB_SPIN_CAP) { atomicAdd(&(bar)[XB_TMO], 1u); break; } } } } while (0)

struct XcdBarrier {
    unsigned* bar; unsigned x;
    volatile LAS unsigned* st;
};

__device__ __forceinline__ XcdBarrier xcd_barrier_post(unsigned* bar, volatile LAS unsigned* st) {
    XcdBarrier b; b.bar = bar; b.x = xb_xcc_id(); b.st = st;
    if (threadIdx.x == 0) st[2] = xb_add(&bar[XB_XCNT(b.x)], 1u);
    return b;
}
__device__ __forceinline__ void xcd_barrier_complete(unsigned* bar, unsigned x, unsigned& nloc, unsigned& nx, unsigned& regular) {
    const unsigned G = gridDim.x * gridDim.y * gridDim.z;
    unsigned sum, cnt, mine, reg, sp = 0u;
    for (;;) {
        sum = 0u; cnt = 0u; mine = 0u; reg = 1u;
#pragma unroll
        for (unsigned j = 0; j < 16; ++j) { const unsigned c = xb_ld(&bar[XB_XCNT(j)]); sum += c; cnt += (c > 0u) ? 1u : 0u; mine = (j == x) ? c : mine; reg = (c == (j < 8u ? G / 8u : 0u)) ? reg : 0u; }
        if (sum == G) break;
        __builtin_amdgcn_s_sleep(1);
        if ((++sp & 255u) == 0u) { if (xb_ld(&bar[XB_TMO])) break; if (sp > XB_SPIN_CAP) { atomicAdd(&bar[XB_TMO], 1u); break; } }
    }
    nloc = mine > 0u ? mine : 1u; nx = cnt > 0u ? cnt : 1u; regular = (sum == G && (G & 7u) == 0u) ? reg : 0u;
}

__device__ __forceinline__ void xcd_barrier(const XcdBarrier& b, int local = 0) {
    asm volatile("s_waitcnt vmcnt(0)" ::: "memory");
    __syncthreads();
    if (threadIdx.x == 0) {
        unsigned* bar = b.bar;
        __builtin_amdgcn_s_waitcnt(0);
        unsigned nloc = b.st[0], nx = b.st[1];
        if (nloc == 0u) { unsigned rg; xcd_barrier_complete(bar, b.x, nloc, nx, rg); b.st[0] = nloc; b.st[1] = nx; b.st[3] = rg; }
        if (local == 2 && nloc != 0u && b.st[3] != 0u) {
            const unsigned j = b.x * 8u + (b.st[2] & 7u);
            __hip_atomic_fetch_add(&bar[XB_XPAN(b.x)], 1u, __ATOMIC_RELAXED, __HIP_MEMORY_SCOPE_AGENT);
            const unsigned old = xb_add(&bar[XB_PSUB(j)], 1u);
            const unsigned gen = old >> 2;
            if ((old & 3u) == 3u) { __builtin_amdgcn_fence(__ATOMIC_ACQUIRE, "agent"); xb_add(&bar[XB_PGEN(j)], 1u); asm volatile("s_waitcnt vmcnt(0)" ::: "memory"); }
            else { XB_SPIN(xb_ld(&bar[XB_PGEN(j)]) == gen, bar); __builtin_amdgcn_fence(__ATOMIC_ACQUIRE, "agent"); asm volatile("s_waitcnt vmcnt(0)" ::: "memory"); }
        } else {
        const unsigned old = xb_add(&bar[XB_XSUB(b.x)], 1u);
        const unsigned gen = old / nloc;
        const bool loc = (local != 0) && b.st[3] != 0u;
        if (old + 1u == (gen + 1u) * nloc) {
          if (!loc) {
            __builtin_amdgcn_fence(__ATOMIC_RELEASE, "agent");
            asm volatile("s_waitcnt vmcnt(0)" ::: "memory");
            const unsigned og = xb_add(&bar[XB_TOP], 1u);
            const unsigned tg = og / nx;
            if (og + 1u == (tg + 1u) * nx) xb_add(&bar[XB_TOPGEN], 1u);
            else XB_SPIN(xb_ld(&bar[XB_TOPGEN]) == tg, bar);
          }
            __builtin_amdgcn_fence(__ATOMIC_ACQUIRE, "agent");
            xb_add(&bar[XB_XGEN(b.x)], 1u);
            asm volatile("s_waitcnt vmcnt(0)" ::: "memory");
        } else {
            XB_SPIN(xb_ld(&bar[XB_XGEN(b.x)]) == gen, bar);
            __builtin_amdgcn_fence(__ATOMIC_ACQUIRE, "agent");
            asm volatile("s_waitcnt vmcnt(0)" ::: "memory");
        }
        }
    }
    __syncthreads();
}

__device__ __forceinline__ void xcc_progress_wait(const XcdBarrier& b, unsigned gen) {
    if (threadIdx.x == 0 && b.st[3] != 0u) {
#pragma unroll 1
        for (unsigned j = 0; j < 8; ++j) XB_SPIN(xb_ld(&b.bar[XB_XPAN(j)]) < 32u * gen, b.bar);
    }
    __syncthreads();
}

struct EpiResidFinal {
    static constexpr bool PERM = true, AFTER_DRAIN = false, SHADOW = false, KEEP_ACC = false;
    const bf16* base; float* RS; float* out; const float* fw; float scale; XcdBarrier bar;
    __device__ __forceinline__ void pre_store(int) const {}
    __device__ __forceinline__ void operator()(const pg8::f32x4 (&acc_)[2][2][4][2], const pg8::Unit& u, int wr, int wc, int fr, int fq) const {
        pg8::f32x4 (&acc)[2][2][4][2] = const_cast<pg8::f32x4 (&)[2][2][4][2]>(acc_);
        const int row0 = u.pm * pg8::BM + wr * 64 + fr; const int col0 = u.pn * pg8::BM + wc * 32 + 8 * fq;
#pragma unroll
        for (int i = 0; i < 8; ++i) { const int ai = i >> 2, m = i & 3; const int row = row0 + ai * pg8::HALF + m * 16; float s = 0.f;
#pragma unroll
            for (int bj = 0; bj < 2; ++bj) { const v4u bw = *(const v4u*)(base + (size_t)row * 1024 + col0 + bj * pg8::HALF);
                pg8::f32x4 x0 = acc[ai][bj][m][0] * scale, x1 = acc[ai][bj][m][1] * scale;
                x0[0] += bflo(bw.x); x0[1] += bfhi(bw.x); x0[2] += bflo(bw.y); x0[3] += bfhi(bw.y); x1[0] += bflo(bw.z); x1[1] += bfhi(bw.z); x1[2] += bflo(bw.w); x1[3] += bfhi(bw.w);
                acc[ai][bj][m][0] = x0; acc[ai][bj][m][1] = x1;
                s += ((x0[0] * x0[0] + x0[1] * x0[1]) + (x0[2] * x0[2] + x0[3] * x0[3])) + ((x1[0] * x1[0] + x1[1] * x1[1]) + (x1[2] * x1[2] + x1[3] * x1[3])); }
            s += __shfl_xor(s, 16); s += __shfl_xor(s, 32);
            if (fq == 0) RS[(size_t)row * 16 + u.pn * 4 + wc] = s; }
        xcd_barrier(bar, 2);
        float rs8[8]; pg8::rows_rstd8(RS, row0, fq, rs8);
        pg8::f32x4 wv[2][2];
#pragma unroll
        for (int bj = 0; bj < 2; ++bj) { wv[bj][0] = *(const pg8::f32x4*)(fw + col0 + bj * pg8::HALF); wv[bj][1] = *(const pg8::f32x4*)(fw + col0 + bj * pg8::HALF + 4); }
#pragma unroll
        for (int i = 0; i < 8; ++i) { const int ai = i >> 2, m = i & 3; const int row = row0 + ai * pg8::HALF + m * 16; const float rs = rs8[i];
#pragma unroll
            for (int bj = 0; bj < 2; ++bj) { float* o = out + (size_t)row * 1024 + col0 + bj * pg8::HALF;
                *(pg8::f32x4*)o = acc[ai][bj][m][0] * rs * wv[bj][0]; *(pg8::f32x4*)(o + 4) = acc[ai][bj][m][1] * rs * wv[bj][1]; } }
    }
};

#ifndef STAGGER_TICKS
#define STAGGER_TICKS 1200ull
#endif
#ifndef PROBE_MASK
#define PROBE_MASK 0
#endif
constexpr int NSUB = 12, N_PHASES = NSUB * DEPTH;
__device__ __forceinline__ void run_phase(Frame& F, KArgs a, int p, bool dry, const XcdBarrier& bar) {
    unsigned char* ws = a->ws; const int l = p / NSUB, sub = p % NSUB;
    bf16* XB = (bf16*)(ws + WS_XB); float* RS = (float*)(ws + WS_RS);
    unsigned* const xsub = (((volatile LAS unsigned*)(F.lds + XB_LDS_OFF))[3] != 0u) ? (unsigned*)(ws + WS_CTL) + XB_XSUB(0) : nullptr;
    unsigned* const xpan = (xsub != nullptr) ? (unsigned*)(ws + WS_CTL) + XB_XPAN(0) : nullptr;
    const unsigned seam0 = (l == 0) ? 1u : (unsigned)NSUB;
#define WAR_EARLY(base_, need_) (((base_) != nullptr && (F.tid & 63) < 8) ? __hip_atomic_load((base_) + 64 * (F.tid & 63), __ATOMIC_RELAXED, __HIP_MEMORY_SCOPE_AGENT) : (need_))
#define WAR_PTR(base_, pv_, need_) (((base_) != nullptr && !__all((pv_) >= (need_))) ? (base_) : nullptr)
    switch (sub) {
    case 0: if (l == 0) phase_prep(F, a, 0, (F.G == 256) ? (1 | 2 | 8) : (1 | 16 | 4 | 8), F.vcu * NWAVES + F.wave, F.G * NWAVES); break;
    case 1: case 10: {
        pg8::Gemm g{XB, (const bf16*)(ws + (sub == 1 ? WS_W1 : WS_W3)), 0, 0, D};
        pg8::StaticOrder S; S.init(M, 2 * FF, F.G, F.vbx);
        const unsigned need = 32u * (4u * l + 3u); const unsigned pv = (sub == 10) ? WAR_EARLY(xpan, need) : need;
        pg8::lds_fp tab = (pg8::lds_fp)(F.lds + RING_BYTES); pg8::fill_rstd_table(S, RS, tab, F.tid);
        pg8::EpiSwiGLU E{slotp(ws, 0), tab, (sub == 10) ? WAR_PTR(xpan, pv, need) : nullptr, need};
        pg8::gemm_phase<pg8::EpiSwiGLU, pg8::StaticOrder, true, true>(F.lds, g, S, E);
        if (F.G == 256 && F.vbx >= 128 && !dry) { const int gw2 = (F.vbx - 128) * NWAVES + F.wave;
            if (sub == 1) phase_prep(F, a, l, (l == 0) ? (4 | 16) : (2 | 16), gw2, 128 * NWAVES); else if (l + 1 < DEPTH) { xcc_progress_wait(bar, (unsigned)(4 * l + 3));        phase_prep(F, a, l + 1, 1 | 4, gw2, 128 * NWAVES); } }
        else if (F.G != 256 && !dry) { const int gw2 = F.vcu * NWAVES + F.wave; if (sub == 1) phase_prep(F, a, l, 2, gw2, F.G * NWAVES); else if (l + 1 < DEPTH) phase_prep(F, a, l + 1, 1 | 16 | 4, gw2, F.G * NWAVES); }
    } break;
    case 2: case 11: case 9: {
        const bf16* A = (sub == 9) ? slotp(ws, S_MG) : slotp(ws, 0); const bf16* B = (const bf16*)(ws + (sub == 2 ? WS_W2 : (sub == 11 ? WS_W4 : WS_WO)));
        pg8::Gemm g{A, B, 0, 0, (sub == 9) ? D : FF};
        pg8::StaticOrder S; S.init(M, D, F.G, F.vbx);
        if (p == N_PHASES - 1 && !dry) {
            EpiResidFinal E{XB, RS, a->out, a->in[31], 0.5f, bar};
            pg8::gemm_phase<EpiResidFinal, pg8::StaticOrder, true, true>(F.lds, g, S, E);
        } else {
            pg8::EpiResid E{XB, dry ? slotp(ws, 6) : XB, dry ? (float*)slotp(ws, 10) : RS, (sub == 9) ? 1.0f : 0.5f};
            pg8::gemm_phase<pg8::EpiResid, pg8::StaticOrder, false, true>(F.lds, g, S, E);
        }
    } break;
    case 3: {
        if (!dry) job_ff(F, ws);
        pg8::Gemm g{XB, (const bf16*)(ws + WS_WIN), 0, 0, D};
        pg8::StaticOrder S; S.init(M, 4096, F.G, F.vbx);
        const unsigned need = 32u * (4u * l + 1u); const unsigned pv = WAR_EARLY(xpan, need);
        pg8::lds_fp tab = (pg8::lds_fp)(F.lds + RING_BYTES); pg8::fill_rstd_table(S, RS, tab, F.tid);
        pg8::EpiProj E{slotp(ws, 0), tab, C2, WAR_PTR(xpan, pv, need), need};
        pg8::gemm_phase<pg8::EpiProj, pg8::StaticOrder, true, true>(F.lds, g, S, E);
    } break;
    case 4: job_gates(F, a, l); phase_attn(F, a, l, dry); break;
    case 5: {
        if (!dry) job_diff_combine(F, a, l);
        for (int k = 0; k < 2; ++k) mA_unit(F, a, l, (F.vcu >> 5) * 64 + (F.vcu & 31) + 32 * k);
    } break;
    case 6: job_scan(F, a); break;
    case 7: {
        for (int k = 0; k < 2; ++k) mC_unit(F, a, l, (F.vcu >> 5) * 64 + (F.vcu & 31) + 32 * k, dry ? 7 : S_MV);
    } break;
    case 8: {
        pg8::BranchOrder S; S.init(M, D, F.G, F.vbx);
        { pg8::Gemm g{XB, (const bf16*)(ws + WS_WIN) + (size_t)4096 * D, 0, (long)D * D, D};
          pg8::lds_fp tab = (pg8::lds_fp)(F.lds + RING_BYTES); pg8::lds_fp gbl = tab + 7 * 256;
          for (int i = F.tid; i < 3 * D; i += NWAVES * 64) gbl[i] = a->in[7][(size_t)l * 3 * D + i];
          const unsigned need = 32u * ((l == 0) ? 7u : 14u); const unsigned pv = WAR_EARLY(xsub, need);
          pg8::fill_rstd_table(S, RS, tab, F.tid);
          pg8::EpiGate E{WAR_PTR(xsub, pv, need), need, slotp(ws, S_G0), tab, gbl};
          pg8::gemm_phase<pg8::EpiGate, pg8::BranchOrder, true, true>(F.lds, g, S, E); }
        { const bf16* WBR = (const bf16*)(ws + WS_WBR);
          pg8::Gemm g{slotp(ws, S_DQ), WBR, (long)SLOT_ELEMS, (long)D * 512, 512};
          pg8::EpiBranch E{slotp(ws, S_G0), slotp(ws, S_MG)};
          pg8::gemm_phase<pg8::EpiBranch, pg8::BranchOrder, true, true>(F.lds, g, S, E); }
    } break;
    default: job_final_norm(F, a); break;
    }
#undef WAR_EARLY
#undef WAR_PTR
}

__global__ void __launch_bounds__(NWAVES * 64, 2) mega_fwd(Args a) {
    extern __shared__ __attribute__((aligned(16))) unsigned char lds[];
    Frame F;
    F.lds = (LAS unsigned char*)lds; F.ldsg = (char*)lds;
    F.tid = threadIdx.x; F.wave = __builtin_amdgcn_readfirstlane(F.tid >> 6);
    F.G = gridDim.x; { const int bx = blockIdx.x; F.vbx = bx; F.vcu = (F.G % 8 == 0) ? (bx % 8) * (F.G / 8) + bx / 8 : bx; }
    const int ph_lo = a.ph_lo, ph_hi = a.ph_hi;
    volatile LAS unsigned* bst = (volatile LAS unsigned*)(F.lds + XB_LDS_OFF);
    if (threadIdx.x < 4) bst[threadIdx.x] = 0u;
    __syncthreads();
    XcdBarrier bar = xcd_barrier_post((unsigned*)(a.ws + WS_CTL), bst);
    int p = ph_lo, rep = 0, nsync = 0;
    while (p < ph_hi) {
        KArgs ka = (KArgs)__builtin_amdgcn_kernarg_segment_ptr(); asm volatile("" : "+s"(ka));
        { int t_ = threadIdx.x; asm volatile("" : "+v"(t_)); F.tid = t_; F.wave = __builtin_amdgcn_readfirstlane(t_ >> 6); }
        if (p == NSUB) { ++p; continue; }
        const int sub_ = p % NSUB; const int reps = ((PROBE_MASK >> sub_) & 1) ? 2 : 1;
        run_phase(F, ka, p, rep + 1 < reps, bar);
        if (++rep == reps) { rep = 0; ++p; }
#if MK_COOP
        if (p < ph_hi) { if (nsync++ == 0) cg::this_grid().sync(); else xcd_barrier(bar); }
#else
        if (p < ph_hi) { ++nsync; const int sd = (p - 1) % NSUB; xcd_barrier(bar, (sd <= 1 || sd == NSUB - 1) ? 0 : ((sd == 2 || sd >= 8) ? 2 : 1));
            if (bst[3] != 0u) { const int x_ = __builtin_amdgcn_readfirstlane((int)bar.x), r_ = __builtin_amdgcn_readfirstlane((int)bst[2]); F.vbx = r_ * 8 + x_; F.vcu = x_ * (F.G / 8) + r_; } }
#endif
    }
}

extern "C" void kernel_launch(void* const* d_in, const int* in_sizes, int n_in, void* d_out, int out_size, void* d_ws, size_t ws_size, hipStream_t stream) {
    static int grid = 0;
    if (grid == 0) {
        if (n_in != 32 || in_sizes[0] != M * D || out_size != M * D || ws_size < WS_END) { fprintf(stderr, "kernel_launch: unexpected shapes (n_in %d, in0 %d, out %d, ws %zu < %zu); nothing launched\n", n_in, n_in > 0 ? in_sizes[0] : -1, out_size, ws_size, (size_t)WS_END); grid = -1; return; }
        int dev = 0, cus = 0, per_cu = 0;
        if (hipGetDevice(&dev) != hipSuccess || hipDeviceGetAttribute(&cus, hipDeviceAttributeMultiprocessorCount, dev) != hipSuccess) { grid = -1; return; }
        if (hipFuncSetAttribute((const void*)mega_fwd, hipFuncAttributeMaxDynamicSharedMemorySize, LDS_BYTES) != hipSuccess) { fprintf(stderr, "kernel_launch: hipFuncSetAttribute failed\n"); grid = -1; return; }
        if (hipOccupancyMaxActiveBlocksPerMultiprocessor(&per_cu, (const void*)mega_fwd, NWAVES * 64, LDS_BYTES) != hipSuccess || per_cu < 1) { fprintf(stderr, "kernel_launch: occupancy query says %d blocks per CU; nothing launched\n", per_cu); (void)hipGetLastError(); grid = -1; return; }
        if (cus != 256) { fprintf(stderr, "kernel_launch: built for a 256-CU device (one 256x256 tile per workgroup in the single-round phases); found %d CUs; nothing launched\n", cus); grid = -1; return; }
        grid = cus;
    }
    if (grid < 0) return;
    if (hipMemsetAsync((char*)d_ws + WS_CTL, 0, 65536, stream) != hipSuccess) { fprintf(stderr, "kernel_launch: hipMemsetAsync failed\n"); return; }
    Args a{};
    for (int i = 0; i < 32; ++i) a.in[i] = (const float*)d_in[i];
    a.out = (float*)d_out; a.ws = (unsigned char*)d_ws;
#if MK_N_LAUNCHES == 1 && MK_COOP
    a.ph_lo = 0; a.ph_hi = N_PHASES;
    void* args[] = {&a};
    hipError_t e = hipLaunchCooperativeKernel((const void*)mega_fwd, dim3(grid), dim3(NWAVES * 64), args, LDS_BYTES, stream);
    if (e != hipSuccess) fprintf(stderr, "kernel_launch: cooperative launch failed: %s (grid %d)\n", hipGetErrorString(e), grid);
#elif MK_N_LAUNCHES == 1
    a.ph_lo = 0; a.ph_hi = N_PHASES;
    hipLaunchKernelGGL(mega_fwd, dim3(grid), dim3(NWAVES * 64), LDS_BYTES, stream, a);
#else
    for (int p = 0; p < N_PHASES; ++p) { a.ph_lo = p; a.ph_hi = p + 1; hipLaunchKernelGGL(mega_fwd, dim3(grid), dim3(NWAVES * 64), LDS_BYTES, stream, a); }
#endif
}
```

```cpp
#include <hip/hip_runtime.h>
#include <hip/hip_cooperative_groups.h>
#include <cstdio>
#include <cstdint>
#include <cmath>
namespace cg = cooperative_groups;

#ifndef MK_COOP
#define MK_COOP 0
#endif
#ifndef MK_N_LAUNCHES
#define MK_N_LAUNCHES 1
#endif

constexpr size_t SLOT_STRIDE_E = (size_t)16384 * 512 + 12288;

namespace pg8 {
#define PG8_LAS __attribute__((address_space(3)))
typedef unsigned short bf16_t;
typedef short bf16x8 __attribute__((ext_vector_type(8)));
typedef float f32x4 __attribute__((ext_vector_type(4)));
typedef unsigned u32x4 __attribute__((ext_vector_type(4)));
typedef unsigned u32x2 __attribute__((ext_vector_type(2)));
constexpr int BM = 256, BK = 64, HALF = 128, HTB = HALF * BK * 2  , STAGE_BYTES = 8 * HTB, NXCD = 8, WGM = 8;

__host__ __device__ __forceinline__ int lds_byte(int r, int c) { const int st = (r >> 4) * 2 + (c >> 5), rr = r & 15, cc = c & 31, ob = rr * 64 + cc * 2; return st * 1024 + (ob ^ (((ob >> 9) & 1) << 5)); }
__host__ __device__ __forceinline__ void stage_rc(int b, int& R, int& C) { const int st = b / 1024, sb = b % 1024, swz = sb ^ (((sb >> 9) & 1) << 5); R = (st >> 1) * 16 + swz / 64; C = (st & 1) * 32 + (swz % 64) / 2; }
__host__ __device__ __forceinline__ int perm32(int rho) { const int n = rho >> 4, i = rho & 15; return 8 * (i >> 2) + 4 * n + (i & 3); }

struct Unit { int pm, pn, z, ord; };
struct Gemm { const bf16_t* A; const bf16_t* B; long azs, bzs; int K;
    __device__ __forceinline__ const char* a(int z) const { return (const char*)(A + (long)z * azs); }
    __device__ __forceinline__ const char* b(int z) const { return (const char*)(B + (long)z * bzs); } };

struct StaticOrder {
    int nM, nN, nwg, G, c;
    __host__ __device__ void init(int M, int N, int G_, int c_) { nM = M / BM; nN = N / BM; nwg = nM * nN; G = G_; c = c_; }
    __host__ __device__ bool next(int i, Unit& u) const {
        const long L = (long)i * G + c; if (L >= nwg) return false;
        int wgid = (int)L; { const int q = nwg / NXCD, r = nwg % NXCD, xcd = wgid % NXCD, off = wgid / NXCD; wgid = (xcd < r ? xcd * (q + 1) : r * (q + 1) + (xcd - r) * q) + off; }
        const int nig = WGM * nN, gid = wgid / nig, fm = gid * WGM, gsz = (nM - fm) < WGM ? (nM - fm) : WGM;
        u.pm = fm + ((wgid % nig) % gsz); u.pn = (wgid % nig) / gsz; u.z = 0; u.ord = i; return true;
    }
    __device__ __forceinline__ void a_ready(const Unit&) const {}
    __device__ __forceinline__ void done(const Unit&) const {}
};

typedef float f32x2_t __attribute__((ext_vector_type(2))); typedef __bf16 bf16x2_t __attribute__((ext_vector_type(2)));
__device__ __forceinline__ unsigned pkbf(float lo, float hi) { f32x2_t v = {lo, hi}; bf16x2_t b = __builtin_convertvector(v, bf16x2_t); return __builtin_bit_cast(unsigned, b); }
__device__ __forceinline__ float bflo(unsigned w) { return __builtin_bit_cast(float, w << 16); }
__device__ __forceinline__ float bfhi(unsigned w) { return __builtin_bit_cast(float, w & 0xffff0000u); }
constexpr float RMS_EPS_F = 1e-6f;
__device__ __forceinline__ float row_rstd(const float* RS, int row) {
    const f32x4* p = (const f32x4*)(RS + (size_t)row * 16);
    const f32x4 a = p[0], b = p[1], c = p[2], d = p[3];
    const float s = (((a[0] + a[1]) + (a[2] + a[3])) + ((b[0] + b[1]) + (b[2] + b[3]))) + (((c[0] + c[1]) + (c[2] + c[3])) + ((d[0] + d[1]) + (d[2] + d[3])));
    return 1.0f / sqrtf(s * (1.0f / 1024.0f) + RMS_EPS_F);
}
__device__ __forceinline__ void rows_rstd8(const float* RS, int row0, int fq, float (&rs)[8]) {
    f32x4 q[8];
#pragma unroll
    for (int i = 0; i < 8; ++i) q[i] = *(const f32x4*)(RS + (size_t)(row0 + (i >> 2) * HALF + (i & 3) * 16) * 16 + 4 * fq);
#pragma unroll
    for (int i = 0; i < 8; ++i) { float s = (q[i][0] + q[i][1]) + (q[i][2] + q[i][3]); s += __shfl_xor(s, 16); s += __shfl_xor(s, 32); rs[i] = 1.0f / sqrtf(s * (1.0f / 1024.0f) + RMS_EPS_F); }
}
typedef PG8_LAS float* lds_fp;
template <class Sched> __device__ __forceinline__ void fill_rstd_table(const Sched& S, const float* RS, lds_fp tab, int tid) {
    f32x4 q[3][4]; bool ok[3];
#pragma unroll
    for (int k = 0; k < 3; ++k) { Unit v; ok[k] = S.next(2 * k + (tid >> 8), v); const int row = ok[k] ? v.pm * BM + (tid & 255) : 0; const f32x4* p = (const f32x4*)(RS + (size_t)row * 16);
#pragma unroll
        for (int j = 0; j < 4; ++j) q[k][j] = p[j]; }
#pragma unroll
    for (int k = 0; k < 3; ++k) { const f32x4 a = q[k][0], b = q[k][1], c = q[k][2], d = q[k][3];
        const float s = (((a[0] + a[1]) + (a[2] + a[3])) + ((b[0] + b[1]) + (b[2] + b[3]))) + (((c[0] + c[1]) + (c[2] + c[3])) + ((d[0] + d[1]) + (d[2] + d[3])));
        if (ok[k]) tab[(2 * k + (tid >> 8)) * 256 + (tid & 255)] = 1.0f / sqrtf(s * (1.0f / 1024.0f) + RMS_EPS_F); }
    __syncthreads();
}
__device__ __forceinline__ void rows_rstd8_lds(lds_fp tab, int ord, int wr, int fr, float (&rs)[8]) {
#pragma unroll
    for (int i = 0; i < 8; ++i) rs[i] = tab[ord * 256 + (i >> 2) * HALF + wr * 64 + (i & 3) * 16 + fr];
}
__device__ __forceinline__ void prog_wait(unsigned* xsub, unsigned need, int lane) {
    if (xsub) { unsigned sp = 0u;
        for (;;) { const unsigned v = (lane < 8) ? __hip_atomic_load(xsub + 64 * lane, __ATOMIC_RELAXED, __HIP_MEMORY_SCOPE_AGENT) : need;
            if (__all(v >= need)) break; __builtin_amdgcn_s_sleep(1); if (++sp > (1u << 20)) break; } } }
__device__ __forceinline__ float sigmoidf_(float x) { return __builtin_amdgcn_rcpf(1.0f + __expf(-x)); }

struct EpiSwiGLU {
    static constexpr bool PERM = true, AFTER_DRAIN = false, KEEP_ACC = false;
    bf16_t* H; lds_fp tab; unsigned* xsub; unsigned need;
    __device__ __forceinline__ void pre_store(int lane) const { prog_wait(xsub, need, lane); }
    __device__ __forceinline__ void operator()(const f32x4 (&acc)[2][2][4][2], const Unit& u, int wr, int wc, int fr, int fq) const {
        const int row0 = u.pm * BM + wr * 64 + fr; const int col0 = u.pn * 128 + wc * 32 + 8 * fq;
        float rs8[8]; rows_rstd8_lds(tab, u.ord, wr, fr, rs8);
#pragma unroll
        for (int ai = 0; ai < 2; ++ai)
#pragma unroll
            for (int m = 0; m < 4; ++m) { const int row = row0 + ai * HALF + m * 16; const float rs = rs8[ai * 4 + m];
                const float c = -1.4426950408889634f * rs, rs2 = rs * rs;
                float hv[8];
#pragma unroll
                for (int n = 0; n < 2; ++n) { const f32x4 g = acc[ai][0][m][n], up = acc[ai][1][m][n]; const f32x4 t = g * c; f32x4 r;
#pragma unroll
                    for (int i = 0; i < 4; ++i) r[i] = __builtin_amdgcn_exp2f(t[i]);
                    r = r + 1.0f;
#pragma unroll
                    for (int i = 0; i < 4; ++i) r[i] = __builtin_amdgcn_rcpf(r[i]);
                    const f32x4 h = (g * up) * (r * rs2);
#pragma unroll
                    for (int i = 0; i < 4; ++i) hv[4 * n + i] = h[i]; }
                u32x4 w; w.x = pkbf(hv[0], hv[1]); w.y = pkbf(hv[2], hv[3]); w.z = pkbf(hv[4], hv[5]); w.w = pkbf(hv[6], hv[7]);
                *(u32x4*)(H + (size_t)row * 2816 + col0) = w; }
    }
};
struct EpiResid {
    static constexpr bool PERM = true, AFTER_DRAIN = false, KEEP_ACC = false;
    const bf16_t* base; bf16_t* XB; float* RS; float scale;
    __device__ __forceinline__ void pre_store(int) const {}
    __device__ __forceinline__ void operator()(const f32x4 (&acc)[2][2][4][2], const Unit& u, int wr, int wc, int fr, int fq) const {
        const int row0 = u.pm * BM + wr * 64 + fr; const int col0 = u.pn * BM + wc * 32 + 8 * fq;
        u32x4 nb[2];
#pragma unroll
        for (int bj = 0; bj < 2; ++bj) nb[bj] = *(const u32x4*)(base + (size_t)row0 * 1024 + col0 + bj * HALF);
#pragma unroll
        for (int i = 0; i < 8; ++i) { const int ai = i >> 2, m = i & 3; const int row = row0 + ai * HALF + m * 16; const size_t off = (size_t)row * 1024 + col0; float s = 0.f;
            u32x4 cb[2];
#pragma unroll
            for (int bj = 0; bj < 2; ++bj) cb[bj] = nb[bj];
            if (i < 7) { const int rown = row0 + ((i + 1) >> 2) * HALF + ((i + 1) & 3) * 16;
#pragma unroll
                for (int bj = 0; bj < 2; ++bj) nb[bj] = *(const u32x4*)(base + (size_t)rown * 1024 + col0 + bj * HALF); }
#pragma unroll
            for (int bj = 0; bj < 2; ++bj) { const u32x4 bw = cb[bj]; const f32x4 a0 = acc[ai][bj][m][0] * scale, a1 = acc[ai][bj][m][1] * scale;
                u32x4 w; w.x = pkbf(bflo(bw.x) + a0[0], bfhi(bw.x) + a0[1]); w.y = pkbf(bflo(bw.y) + a0[2], bfhi(bw.y) + a0[3]); w.z = pkbf(bflo(bw.z) + a1[0], bfhi(bw.z) + a1[1]); w.w = pkbf(bflo(bw.w) + a1[2], bfhi(bw.w) + a1[3]);
                *(u32x4*)(XB + off + bj * HALF) = w;
                const float x0 = bflo(w.x), x1 = bfhi(w.x), x2 = bflo(w.y), x3 = bfhi(w.y), x4 = bflo(w.z), x5 = bfhi(w.z), x6 = bflo(w.w), x7 = bfhi(w.w);
                s += ((x0 * x0 + x1 * x1) + (x2 * x2 + x3 * x3)) + ((x4 * x4 + x5 * x5) + (x6 * x6 + x7 * x7)); }
            s += __shfl_xor(s, 16); s += __shfl_xor(s, 32);
            if (fq == 0) RS[(size_t)row * 16 + u.pn * 4 + wc] = s;
            asm volatile("" ::: "memory"); }
    }
};
struct EpiProj {
    static constexpr bool PERM = true, AFTER_DRAIN = false, KEEP_ACC = false;
    bf16_t* SLOT; lds_fp tab; float qscale; unsigned* xsub; unsigned need;
    __device__ __forceinline__ void pre_store(int lane) const { prog_wait(xsub, need, lane); }
    __device__ __forceinline__ void operator()(const f32x4 (&acc)[2][2][4][2], const Unit& u, int wr, int wc, int fr, int fq) const {
        const int grp = u.pn >> 1; const int slot = (int)((0x43761520u >> (4 * grp)) & 15u); const float sc = (grp == 0 || grp == 3) ? qscale : 1.0f;
        bf16_t* dst = SLOT + (size_t)slot * SLOT_STRIDE_E;
        const int row0 = u.pm * BM + wr * 64 + fr; const int col0 = (u.pn & 1) * 256 + wc * 32 + 8 * fq;
        float rs8[8]; rows_rstd8_lds(tab, u.ord, wr, fr, rs8);
#pragma unroll
        for (int ai = 0; ai < 2; ++ai)
#pragma unroll
            for (int m = 0; m < 4; ++m) { const int row = row0 + ai * HALF + m * 16; const float rs = rs8[ai * 4 + m] * sc;
#pragma unroll
                for (int bj = 0; bj < 2; ++bj) { const f32x4 v0 = acc[ai][bj][m][0] * rs, v1 = acc[ai][bj][m][1] * rs;
                    u32x4 w; w.x = pkbf(v0[0], v0[1]); w.y = pkbf(v0[2], v0[3]); w.z = pkbf(v1[0], v1[1]); w.w = pkbf(v1[2], v1[3]);
                    *(u32x4*)(dst + (size_t)row * 512 + col0 + bj * HALF) = w; } }
    }
};
struct EpiGate {
    static constexpr bool PERM = true, AFTER_DRAIN = false, KEEP_ACC = false;
    unsigned* xsub; unsigned need;
    __device__ __forceinline__ void pre_store(int lane) const { prog_wait(xsub, need, lane); }
    bf16_t* G; lds_fp tab; lds_fp gb_lds;
    __device__ __forceinline__ void operator()(const f32x4 (&acc)[2][2][4][2], const Unit& u, int wr, int wc, int fr, int fq) const {
        const int gi = u.z; unsigned char* dst = (unsigned char*)(G + (size_t)gi * SLOT_STRIDE_E);
        const int row0 = u.pm * BM + wr * 64 + fr; const int col0 = u.pn * 256 + wc * 32 + 8 * fq; const lds_fp gb = gb_lds + gi * 1024 + col0;
        f32x4 bv[2][2];
#pragma unroll
        for (int bj = 0; bj < 2; ++bj)
#pragma unroll
            for (int n = 0; n < 2; ++n) bv[bj][n] = *(const PG8_LAS f32x4*)(gb + bj * HALF + 4 * n) * (-1.4426950408889634f);
        float rs8[8]; rows_rstd8_lds(tab, u.ord, wr, fr, rs8);
#pragma unroll
        for (int ai = 0; ai < 2; ++ai)
#pragma unroll
            for (int m = 0; m < 4; ++m) { const float c = -1.4426950408889634f * rs8[ai * 4 + m]; u32x4 wq;
#pragma unroll
                for (int bj = 0; bj < 2; ++bj) { f32x4 v0 = acc[ai][bj][m][0] * c + bv[bj][0], v1 = acc[ai][bj][m][1] * c + bv[bj][1];
#pragma unroll
                    for (int i = 0; i < 4; ++i) { v0[i] = __builtin_amdgcn_exp2f(v0[i]); v1[i] = __builtin_amdgcn_exp2f(v1[i]); }
                    v0 = v0 + 1.0f; v1 = v1 + 1.0f;
#pragma unroll
                    for (int i = 0; i < 4; ++i) { v0[i] = __builtin_amdgcn_rsqf(v0[i]); v1[i] = __builtin_amdgcn_rsqf(v1[i]); }
                    v0 = v0 * 255.0f; v1 = v1 * 255.0f; u32x2 w; w.x = 0u; w.y = 0u;
#pragma unroll
                    for (int i = 0; i < 4; ++i) { v0[i] = __builtin_fmaxf(v0[i], 1.0f); v1[i] = __builtin_fmaxf(v1[i], 1.0f); }
#pragma unroll
                    for (int i = 0; i < 4; ++i) { w.x = __builtin_amdgcn_cvt_pk_u8_f32(v0[i], i, w.x); w.y = __builtin_amdgcn_cvt_pk_u8_f32(v1[i], i, w.y); }
                    if (bj == 0) { wq.x = w.x; wq.y = w.y; } else { wq.z = w.x; wq.w = w.y; } }
                *(u32x4*)(dst + ((((size_t)(u.pm * 4 + u.pn) * 8 + (wr * 4 + wc)) * 8 + (ai * 4 + m)) * 64 + (fr + 16 * fq)) * 16) = wq; }
    }
};
struct EpiBranch {
    static constexpr bool PERM = true, AFTER_DRAIN = false, KEEP_ACC = true;
    const bf16_t* Gb; bf16_t* MG;
    __device__ __forceinline__ void pre_store(int) const {}
    __device__ __forceinline__ void operator()(const f32x4 (&acc_)[2][2][4][2], const Unit& u, int wr, int wc, int fr, int fq) const {
        f32x4 (&acc)[2][2][4][2] = const_cast<f32x4 (&)[2][2][4][2]>(acc_);
        const unsigned char* G = (const unsigned char*)(Gb + (size_t)u.z * SLOT_STRIDE_E);
        const unsigned char* Gn = G + SLOT_STRIDE_E * 2;
        const int row0 = u.pm * BM + wr * 64 + fr; const int col0 = u.pn * BM + wc * 32 + 8 * fq; const bool fin = (u.z == 2);
        const size_t fo = (((size_t)(u.pm * 4 + u.pn) * 8 + (wr * 4 + wc)) * 8) * 1024 + (size_t)(fr + 16 * fq) * 16;
        u32x4 ngq, nnq;
        ngq = *(const u32x4*)(G + fo); if (!fin) nnq = *(const u32x4*)(Gn + fo); else nnq = ngq;
#pragma unroll
        for (int i = 0; i < 8; ++i) { const int ai = i >> 2, m = i & 3; const int row = row0 + ai * HALF + m * 16;
            u32x2 cg[2], cn[2];
            cg[0] = (u32x2){ngq.x, ngq.y}; cg[1] = (u32x2){ngq.z, ngq.w}; cn[0] = (u32x2){nnq.x, nnq.y}; cn[1] = (u32x2){nnq.z, nnq.w};
            if (i < 7) { ngq = *(const u32x4*)(G + fo + (size_t)(i + 1) * 1024); if (!fin) nnq = *(const u32x4*)(Gn + fo + (size_t)(i + 1) * 1024); else nnq = ngq; }
#pragma unroll
            for (int bj = 0; bj < 2; ++bj) { const u32x2 gw = cg[bj], gn = cn[bj];
                float gz[8] = {(float)(gw.x & 255u), (float)((gw.x >> 8) & 255u), (float)((gw.x >> 16) & 255u), (float)(gw.x >> 24), (float)(gw.y & 255u), (float)((gw.y >> 8) & 255u), (float)((gw.y >> 16) & 255u), (float)(gw.y >> 24)};
                float gd[8] = {(float)(gn.x & 255u), (float)((gn.x >> 8) & 255u), (float)((gn.x >> 16) & 255u), (float)(gn.x >> 24), (float)(gn.y & 255u), (float)((gn.y >> 8) & 255u), (float)((gn.y >> 16) & 255u), (float)(gn.y >> 24)};
                f32x4 r0, r1;
#pragma unroll
                for (int k = 0; k < 4; ++k) { r0[k] = fin ? gz[k] * (1.0f / 255.0f) : gz[k] * __builtin_amdgcn_rcpf(gd[k]); r1[k] = fin ? gz[4 + k] * (1.0f / 255.0f) : gz[4 + k] * __builtin_amdgcn_rcpf(gd[4 + k]); }
                r0 = r0 * r0; r1 = r1 * r1;
                const f32x4 a0 = acc[ai][bj][m][0] * r0, a1 = acc[ai][bj][m][1] * r1;
                acc[ai][bj][m][0] = a0; acc[ai][bj][m][1] = a1;
                if (fin) { u32x4 w; w.x = pkbf(a0[0], a0[1]); w.y = pkbf(a0[2], a0[3]); w.z = pkbf(a1[0], a1[1]); w.w = pkbf(a1[2], a1[3]);
                    *(u32x4*)(MG + (size_t)row * 1024 + col0 + bj * HALF) = w; } }
            asm volatile("" ::: "memory"); }
    }
};
struct BranchOrder {
    StaticOrder so;
    __device__ void init(int M, int N, int G_, int c_) { so.init(M, N, G_, c_); }
    __device__ bool next(int i, Unit& u) const { const int t = i / 3; if (!so.next(t, u)) return false; u.z = i - 3 * t; return true; }
    __device__ __forceinline__ void a_ready(const Unit&) const {}
    __device__ __forceinline__ void done(const Unit&) const {}
};
template <class Epi, class Sched, bool ALIGN_EPI = false, bool SP2 = false>
__device__ __forceinline__ void gemm_phase(PG8_LAS unsigned char* lds, const Gemm g, const Sched& S, const Epi& E) {
    int tid_ = threadIdx.x; asm volatile("" : "+v"(tid_));
    const int tid = tid_, wid = __builtin_amdgcn_readfirstlane(tid >> 6), lane = tid & 63, wr = wid >> 2, wc = wid & 3, fr = lane & 15, fq = lane >> 4;
    const int K = g.K, nt = K / BK;
    unsigned voffA[2], voffB[2];
#pragma unroll
    for (int i = 0; i < 2; ++i) { int R, C; stage_rc(tid * 16 + i * 8192, R, C); const int Rb = Epi::PERM ? ((R & ~31) + perm32(R & 31)) : R;
        voffA[i] = (unsigned)(R * K + C) * 2u; voffB[i] = (unsigned)(Rb * K + C) * 2u; }
    const size_t kstep = (size_t)(BK * 2);
    const size_t hstep = (size_t)HALF * K * 2;
    const size_t tstep = 2 * hstep;
    const unsigned ldsw = (unsigned)wid * 1024u;
    const int aoff = lds_byte(wr * 64 + fr, fq * 8), boff = lds_byte(wc * 32 + fr, fq * 8);
#define PG8_SA(b, h) (((b) * 2 + (h)) * HTB)
#define PG8_SB(b, h) ((4 + (b) * 2 + (h)) * HTB)
#define PG8_STAGE(bufoff, gbase, voff) do { _Pragma("unroll") for (int _i = 0; _i < 2; ++_i) \
        __builtin_amdgcn_global_load_lds((const unsigned*)((const char*)(gbase) + (voff)[_i]), (PG8_LAS unsigned*)(lds + (bufoff) + ldsw + _i * 8192), 16, 0, 0); } while (0)
#define PG8_LDA(dst, b, h) do { _Pragma("unroll") for (int m = 0; m < 4; ++m) _Pragma("unroll") for (int k = 0; k < 2; ++k) dst[m][k] = *(const PG8_LAS bf16x8*)(lds + PG8_SA(b, h) + aoff + m * 2048 + k * 1024); } while (0)
#define PG8_LDB(dst, b, h) do { _Pragma("unroll") for (int n = 0; n < 2; ++n) _Pragma("unroll") for (int k = 0; k < 2; ++k) dst[n][k] = *(const PG8_LAS bf16x8*)(lds + PG8_SB(b, h) + boff + n * 2048 + k * 1024); } while (0)
#define PG8_MMA(ai, bj, At, Bt) do { __builtin_amdgcn_s_setprio(1); _Pragma("unroll") for (int m = 0; m < 4; ++m) _Pragma("unroll") for (int n = 0; n < 2; ++n) _Pragma("unroll") for (int k = 0; k < 2; ++k) \
        acc[ai][bj][m][n] = __builtin_amdgcn_mfma_f32_16x16x32_bf16(Bt[n][k], At[m][k], acc[ai][bj][m][n], 0, 0, 0); __builtin_amdgcn_s_setprio(0); } while (0)
#define PG8_WAIT_V(n) asm volatile("s_waitcnt vmcnt(" #n ")" ::: "memory")
#define PG8_WAIT_L(n) asm volatile("s_waitcnt lgkmcnt(" #n ")" ::: "memory")
#define PG8_BAR __builtin_amdgcn_s_barrier()
#define PG8_SCHED __builtin_amdgcn_sched_barrier(0)
    Unit cur, nxt; int ui = 0;
    if (!S.next(0, cur)) return;
    f32x4 acc[2][2][4][2];
#pragma unroll
    for (int a = 0; a < 2; ++a)
#pragma unroll
        for (int b = 0; b < 2; ++b)
#pragma unroll
            for (int m = 0; m < 4; ++m)
#pragma unroll
                for (int n = 0; n < 2; ++n) acc[a][b][m][n] = (f32x4){0.f, 0.f, 0.f, 0.f};
    bf16x8 At[4][2], B0[2][2], B1[2][2];
    const char* cA = g.a(cur.z) + (size_t)cur.pm * tstep; const char* cB = g.b(cur.z) + (size_t)cur.pn * tstep;
    S.a_ready(cur);
    if constexpr (SP2) {
        PG8_STAGE(PG8_SB(0, 0), cB, voffB); PG8_STAGE(PG8_SB(0, 1), cB + hstep, voffB); PG8_STAGE(PG8_SA(0, 0), cA, voffA); PG8_STAGE(PG8_SA(0, 1), cA + hstep, voffA);
        if (wr == 1) PG8_BAR;
        PG8_WAIT_V(2); PG8_BAR;
        PG8_STAGE(PG8_SB(1, 0), cB + kstep, voffB); PG8_STAGE(PG8_SA(1, 0), cA + kstep, voffA); PG8_STAGE(PG8_SB(1, 1), cB + hstep + kstep, voffB);
        PG8_WAIT_V(6); PG8_BAR;
    } else {
        PG8_STAGE(PG8_SB(0, 0), cB, voffB); PG8_STAGE(PG8_SA(0, 0), cA, voffA); PG8_STAGE(PG8_SB(0, 1), cB + hstep, voffB); PG8_STAGE(PG8_SA(0, 1), cA + hstep, voffA);
        if (wr == 1) PG8_BAR;
        PG8_WAIT_V(4); PG8_BAR;
        PG8_STAGE(PG8_SB(1, 0), cB + kstep, voffB); PG8_STAGE(PG8_SA(1, 0), cA + kstep, voffA); PG8_STAGE(PG8_SB(1, 1), cB + hstep + kstep, voffB);
        PG8_WAIT_V(6); PG8_BAR;
    }
    for (;;) {
        const bool has_next = S.next(ui + 1, nxt);
        const char* nA = has_next ? g.a(nxt.z) + (size_t)nxt.pm * tstep : cA; const char* nB = has_next ? g.b(nxt.z) + (size_t)nxt.pn * tstep : cB;
        for (int t = 0; t < nt; t += 2) {
            const bool last = (t == nt - 2);
            const char* a1 = cA + (size_t)(t + 1) * kstep;
            const char* a2 = last ? nA : cA + (size_t)(t + 2) * kstep; const char* b2 = last ? nB : cB + (size_t)(t + 2) * kstep;
            const char* a3 = a2 + kstep; const char* b3 = b2 + kstep;
            if (last && has_next) S.a_ready(nxt);
            if constexpr (SP2) {
            PG8_LDB(B0, 0, 0); PG8_LDB(B1, 0, 1); PG8_SCHED; PG8_LDA(At, 0, 0); PG8_STAGE(PG8_SA(1, 1), a1 + hstep, voffA);
            PG8_WAIT_V(8); PG8_WAIT_L(0); PG8_BAR; PG8_MMA(0, 0, At, B0); PG8_MMA(0, 1, At, B1); PG8_BAR; PG8_SCHED;
            PG8_LDA(At, 0, 1); PG8_STAGE(PG8_SB(0, 0), b2, voffB); PG8_STAGE(PG8_SB(0, 1), b2 + hstep, voffB); PG8_STAGE(PG8_SA(0, 0), a2, voffA);
            PG8_WAIT_V(8); PG8_WAIT_L(0); PG8_BAR; PG8_MMA(1, 0, At, B0); PG8_MMA(1, 1, At, B1); PG8_BAR; PG8_SCHED;
            PG8_LDB(B0, 1, 0); PG8_LDB(B1, 1, 1); PG8_SCHED; PG8_LDA(At, 1, 0); PG8_STAGE(PG8_SA(0, 1), a2 + hstep, voffA);
            PG8_WAIT_V(8); PG8_WAIT_L(0); PG8_BAR; PG8_MMA(0, 0, At, B0); PG8_MMA(0, 1, At, B1); PG8_BAR; PG8_SCHED;
            PG8_LDA(At, 1, 1); PG8_STAGE(PG8_SB(1, 0), b3, voffB); PG8_STAGE(PG8_SB(1, 1), b3 + hstep, voffB); PG8_STAGE(PG8_SA(1, 0), a3, voffA);
            PG8_WAIT_V(8); PG8_WAIT_L(0); PG8_BAR; PG8_MMA(1, 0, At, B0); PG8_MMA(1, 1, At, B1); PG8_BAR; PG8_SCHED;
            } else {
            PG8_LDB(B0, 0, 0); PG8_SCHED; PG8_LDA(At, 0, 0); PG8_STAGE(PG8_SA(1, 1), a1 + hstep, voffA);
            PG8_WAIT_L(8); PG8_BAR; PG8_WAIT_L(0); PG8_MMA(0, 0, At, B0); PG8_BAR; PG8_SCHED;
            PG8_LDB(B1, 0, 1); PG8_STAGE(PG8_SB(0, 0), b2, voffB);
            PG8_BAR; PG8_WAIT_L(0); PG8_MMA(0, 1, At, B1); PG8_BAR;
            PG8_LDA(At, 0, 1); PG8_STAGE(PG8_SA(0, 0), a2, voffA);
            PG8_BAR; PG8_WAIT_L(0); PG8_MMA(1, 0, At, B0); PG8_BAR; PG8_SCHED;
            PG8_STAGE(PG8_SB(0, 1), b2 + hstep, voffB);
            PG8_WAIT_V(6); PG8_BAR; PG8_MMA(1, 1, At, B1); PG8_BAR;
            PG8_LDB(B0, 1, 0); PG8_SCHED; PG8_LDA(At, 1, 0); PG8_STAGE(PG8_SA(0, 1), a2 + hstep, voffA);
            PG8_WAIT_L(8); PG8_BAR; PG8_WAIT_L(0); PG8_MMA(0, 0, At, B0); PG8_BAR; PG8_SCHED;
            PG8_LDB(B1, 1, 1); PG8_STAGE(PG8_SB(1, 0), b3, voffB);
            PG8_BAR; PG8_WAIT_L(0); PG8_MMA(0, 1, At, B1); PG8_BAR;
            PG8_LDA(At, 1, 1); PG8_STAGE(PG8_SA(1, 0), a3, voffA);
            PG8_BAR; PG8_WAIT_L(0); PG8_MMA(1, 0, At, B0); PG8_BAR; PG8_SCHED;
            PG8_STAGE(PG8_SB(1, 1), b3 + hstep, voffB);
            PG8_WAIT_V(6); PG8_BAR; PG8_MMA(1, 1, At, B1); PG8_BAR;
            }
        }
        if constexpr (ALIGN_EPI) { if (wr == 0) PG8_BAR; }
        if constexpr (!Epi::AFTER_DRAIN) { if (ui == 0) E.pre_store(lane); E(acc, cur, wr, wc, fr, fq); S.done(cur); }
        if (!has_next) break;
        if (!(Epi::KEEP_ACC && nxt.z != 0)) {
#pragma unroll
        for (int a = 0; a < 2; ++a)
#pragma unroll
            for (int b = 0; b < 2; ++b)
#pragma unroll
                for (int m = 0; m < 4; ++m)
#pragma unroll
                    for (int n = 0; n < 2; ++n) acc[a][b][m][n] = (f32x4){0.f, 0.f, 0.f, 0.f};
        }
        cur = nxt; cA = nA; cB = nB; ++ui;
        if constexpr (ALIGN_EPI) { if (wr == 1) PG8_BAR; }
    }
    PG8_WAIT_V(0);
    if constexpr (!ALIGN_EPI) { if (wr == 0) PG8_BAR; }
    PG8_BAR;
    if constexpr (Epi::AFTER_DRAIN) { E.fused(acc, cur, wr, wc, fr, fq, lds, wid, lane); S.done(cur); }
#undef PG8_SA
#undef PG8_SB
#undef PG8_STAGE
#undef PG8_LDA
#undef PG8_LDB
#undef PG8_MMA
#undef PG8_WAIT_V
#undef PG8_WAIT_L
#undef PG8_BAR
#undef PG8_SCHED
}
}
namespace attn {
using bf16x8 = __attribute__((ext_vector_type(8))) short;
using s16x4 = __attribute__((ext_vector_type(4))) short;
using f32x16 = __attribute__((ext_vector_type(16))) float;
using f32x4 = __attribute__((ext_vector_type(4))) float;
using u32x4 = __attribute__((ext_vector_type(4))) unsigned;
typedef unsigned short bf16;
constexpr int SEQ = 2048, DM = 512, NW = 8, QBLK = 32, QB = QBLK * NW, KVBLK = 64;
constexpr int SLOTB = 8192, LDS_K = 0, LDS_V = 3 * SLOTB, LDS_WS = 6 * SLOTB, LDS_OST = LDS_WS + NW * 256, LDS_BIAS = LDS_OST + NW * 4096, LDS_BYTES = LDS_BIAS + SEQ * 4;
constexpr int THR = 64;
#define SBAR() __builtin_amdgcn_sched_barrier(0)
#define PIN(x) asm volatile("" : "+v"(x))
#define MFMA(a, b, c) __builtin_amdgcn_mfma_f32_32x32x16_bf16(a, b, c, 0, 0, 0)
#define WAIT_BAR(N) asm volatile("s_waitcnt vmcnt(" #N ") lgkmcnt(0)\n\ts_barrier" ::: "memory")
__device__ __forceinline__ int crow(int r, int hi) { return (r & 3) + 8 * (r >> 2) + 4 * hi; }
__device__ __forceinline__ unsigned cvtpk(float lo, float hi) { unsigned r; asm("v_cvt_pk_bf16_f32 %0, %1, %2" : "=v"(r) : "v"(lo), "v"(hi)); return r; }
__device__ __forceinline__ void glds16(const void* g, unsigned lds_base) {
    unsigned sv; asm volatile("s_mov_b32 %0, m0\n\ts_mov_b32 m0, %2\n\ts_nop 0\n\tglobal_load_lds_dwordx4 %1, off\n\ts_mov_b32 m0, %0" : "=&s"(sv) : "v"(g), "s"(lds_base) : "memory"); }
typedef __attribute__((address_space(3))) const char* lds_cptr;
typedef short v4i16_t __attribute__((ext_vector_type(4)));
__device__ __forceinline__ void kload2(bf16x8* kf, lds_cptr kp, int d0) { kf[2 * d0] = *(const __attribute__((address_space(3))) bf16x8*)(kp + d0 * 2048); kf[2 * d0 + 1] = *(const __attribute__((address_space(3))) bf16x8*)(kp + d0 * 2048 + 512); }
__device__ __forceinline__ s16x4 vtr(lds_cptr p) { return __builtin_bit_cast(s16x4, __builtin_amdgcn_ds_read_tr16_b64_v4i16((__attribute__((address_space(3))) v4i16_t*)p)); }
#define MX3(a, b, c) __builtin_fmaxf(__builtin_fmaxf((a), (b)), (c))
__device__ __forceinline__ float rowmax(const f32x16& p0, const f32x16& p1) {
    float a = MX3(p0[0], p0[1], p1[0]), b = MX3(p0[2], p0[3], p1[1]); a = MX3(a, p1[2], p1[3]);
#pragma unroll
    for (int r = 4; r < 16; r += 4) { a = MX3(a, p0[r], p0[r + 1]); b = MX3(b, p0[r + 2], p0[r + 3]); a = MX3(a, p1[r], p1[r + 1]); b = MX3(b, p1[r + 2], p1[r + 3]); }
    float m = __builtin_fmaxf(a, b); auto rr = __builtin_amdgcn_permlane32_swap(__float_as_uint(m), __float_as_uint(m), false, false);
    return __builtin_fmaxf(__uint_as_float(rr[0]), __uint_as_float(rr[1])); }
__device__ __forceinline__ void cmask(f32x16& p0, f32x16& p1, int jb, int qrel, int hi) {
    const int kb = 64 * jb + 4 * hi;
#pragma unroll
    for (int r = 0; r < 16; ++r) { const int kv = kb + (r & 3) + 8 * (r >> 2); if (kv > qrel) p0[r] = -INFINITY; if (kv + 32 > qrel) p1[r] = -INFINITY; } }
typedef __attribute__((address_space(3))) const f32x4* lds_f4ptr;
__device__ __forceinline__ void ldbias(f32x16& p0, f32x16& p1, lds_cptr bp) {
    lds_f4ptr b = (lds_f4ptr)bp;
    const f32x4 a0 = b[0], a1 = b[2], a2 = b[4], a3 = b[6], c0 = b[8], c1 = b[10], c2 = b[12], c3 = b[14];
    p0 = (f32x16){a0[0], a0[1], a0[2], a0[3], a1[0], a1[1], a1[2], a1[3], a2[0], a2[1], a2[2], a2[3], a3[0], a3[1], a3[2], a3[3]};
    p1 = (f32x16){c0[0], c0[1], c0[2], c0[3], c1[0], c1[1], c1[2], c1[3], c2[0], c2[1], c2[2], c2[3], c3[0], c3[1], c3[2], c3[3]};
}

constexpr int LDS2_V = 3 * SLOTB, LDS2_WS = LDS2_V + 6 * SLOTB, LDS2_OST = LDS2_WS + NW * 256, LDS2_BIAS = LDS2_OST + NW * 4096, LDS2_Q = LDS2_BIAS + SEQ * 4, LDS2_BYTES = LDS2_Q + NW * 4096;
__device__ __forceinline__ void attn_unit(const bf16* Q, const bf16* __restrict__ K, const bf16* __restrict__ V, bf16* O, int qb, int T0, char* lds) {
    int tid_ = threadIdx.x; asm volatile("" : "+v"(tid_));
    const int tid = tid_, lane = tid & 63, r32 = lane & 31, hi = lane >> 5; const int wid = __builtin_amdgcn_readfirstlane(tid >> 6);
    const int q0 = qb * QB, NT = (q0 + QB) / KVBLK - T0;
    const bf16* Qw = Q + (long)(q0 + wid * QBLK) * DM;
    const unsigned lds0 = (unsigned)(uintptr_t)lds; float* wsf = (float*)(lds + LDS_WS) + wid * 64;
    const bf16* ksrc = K + (long)(T0 * KVBLK + lane) * DM + wid * 8;
    const bf16* vsrc = V + (long)(T0 * KVBLK + 16 * (wid & 3) + (lane >> 2)) * DM + (wid >> 2) * 32 + (lane & 3) * 8;
    const unsigned kdst = lds0 + LDS_K + wid * 1024, vdst = lds0 + LDS_V + wid * 1024;
#define DMA_K(t, slot) glds16(ksrc + (long)(t) * KVBLK * DM, (unsigned)__builtin_amdgcn_readfirstlane(kdst + (slot)))
#define DMA_V(t, slot) glds16(vsrc + (long)(t) * KVBLK * DM, (unsigned)__builtin_amdgcn_readfirstlane(vdst + (slot)))
    const lds_cptr vp0 = (lds_cptr)lds + LDS_V + ((lane >> 4) & 1) * 32 + (lane & 3) * 8 + (4 * hi + ((lane & 15) >> 2)) * 64;
    const lds_cptr kp0 = (lds_cptr)lds + LDS_K + hi * 1024 + r32 * 16;
    const lds_cptr bp0 = (lds_cptr)lds + LDS_BIAS + T0 * 256 + hi * 16;
    DMA_K(0, 0); DMA_V(0, 0); DMA_K(1, SLOTB);
    bf16x8 qr[4];
#pragma unroll
    for (int d0 = 0; d0 < 4; ++d0) qr[d0] = *reinterpret_cast<const bf16x8*>(&Qw[(long)r32 * DM + d0 * 16 + hi * 8]);
    float mhat = 0.f, l_reg = 0.f; f32x16 o[2]; o[0] = f32x16{}; o[1] = f32x16{};
    const int qrel = wid * QBLK + r32; bool resc = false;
    f32x16 pA0, pA1, pB0, pB1; bf16x8 kf[8]; s16x4 vlo[8], vhi[8]; u32x4 pw0, pw1, pw2, pw3;
    int sl_prev = 0, sl_cur = 0, sl_next = SLOTB;
#define ROT() do { sl_prev = sl_cur; sl_cur = sl_next; sl_next = (sl_next == 2 * SLOTB) ? 0 : sl_next + SLOTB; } while (0)
#define EX(v) __builtin_amdgcn_exp2f((v) + nmh)
#define RESC() do { if (resc) { _Pragma("unroll") for (int d_ = 0; d_ < 2; ++d_) _Pragma("unroll") for (int r = 0; r < 16; ++r) o[d_][r] *= wsf[crow(r, hi)]; } } while (0)
    DMA_K(2, 2 * SLOTB);
    ldbias(pA0, pA1, bp0);
    WAIT_BAR(3);
    _Pragma("unroll") for (int d0 = 0; d0 < 4; ++d0) kload2(kf, kp0, d0);
    pA0 = MFMA(kf[0], qr[0], pA0); pA1 = MFMA(kf[1], qr[0], pA1); pA0 = MFMA(kf[2], qr[1], pA0); pA1 = MFMA(kf[3], qr[1], pA1);
    pA0 = MFMA(kf[4], qr[2], pA0); pA1 = MFMA(kf[5], qr[2], pA1); pA0 = MFMA(kf[6], qr[3], pA0); pA1 = MFMA(kf[7], qr[3], pA1);
    if (NT == 4) cmask(pA0, pA1, 0, qrel, hi);
    { const float rm = rowmax(pA0, pA1); mhat = rm; const float nmh = -mhat;
#pragma unroll
      for (int r = 0; r < 16; ++r) { pA0[r] = EX(pA0[r]); pA1[r] = EX(pA1[r]); } }
    ldbias(pB0, pB1, bp0 + 256);
    WAIT_BAR(0);
    DMA_K(3, 0); DMA_V(1, SLOTB); ROT();
    _Pragma("unroll") for (int d0 = 0; d0 < 4; ++d0) kload2(kf, kp0 + sl_cur, d0);
    WAIT_BAR(2);
#define PKW(P, i) cvtpk(P[i], P[i + 1])
#define PAF(k) __builtin_bit_cast(bf16x8, pw##k)
#define VFR(i) (bf16x8){vlo[i][0], vlo[i][1], vlo[i][2], vlo[i][3], vhi[i][0], vhi[i][1], vhi[i][2], vhi[i][3]}
#define VRD(i) do { vlo[i] = vtr(vp_ + (((i) >> 2) * 4096 + ((i) & 3) * 1024)); vhi[i] = vtr(vp_ + (((i) >> 2) * 4096 + ((i) & 3) * 1024 + 512)); } while (0)
#define KRD(G, d0) do { if (G) { kload2(kf, kp0 + sl_next, d0); SBAR(); } } while (0)
#define GAPA(MF, a0, a1, a2, a3, W0, W1, PW) do { MF; sacc += a0; sacc += a1; sacc += a2; sacc += a3; W0; W1; PIN(PW); PIN(sacc); SBAR(); } while (0)
#define GAPB(MF, X, i) do { MF; X[i] = EX(X[i]); X[i + 1] = EX(X[i + 1]); X[i + 2] = EX(X[i + 2]); X[i + 3] = EX(X[i + 3]); PIN(X); SBAR(); } while (0)
#define STEP(C0, C1, P0, P1, t, MASK, GK, GV, GL, GB) do { SBAR(); \
    const lds_cptr vp_ = vp0 + sl_prev; \
    VRD(0); SBAR(); float sacc = P0[0] + P0[1]; \
                    GAPA(C0 = MFMA(kf[0], qr[0], C0), P0[2], P0[3], P0[4], P0[5],     pw0[0] = PKW(P0, 0),  pw0[1] = PKW(P0, 2),  pw0); \
    VRD(4); SBAR(); GAPA(C1 = MFMA(kf[1], qr[0], C1), P0[6], P0[7], P0[8], P0[9],     pw0[2] = PKW(P0, 4),  pw0[3] = PKW(P0, 6),  pw0); \
    VRD(1); SBAR(); GAPA(C0 = MFMA(kf[2], qr[1], C0),    P0[10], P0[11], P0[12], P0[13], pw1[0] = PKW(P0, 8),  pw1[1] = PKW(P0, 10), pw1); \
    VRD(5); SBAR(); GAPA(C1 = MFMA(kf[3], qr[1], C1),    P0[14], P0[15], P1[0], P1[1],   pw1[2] = PKW(P0, 12), pw1[3] = PKW(P0, 14), pw1); \
    VRD(2); SBAR(); GAPA(C0 = MFMA(kf[4], qr[2], C0),    P1[2], P1[3], P1[4], P1[5],     pw2[0] = PKW(P1, 0),  pw2[1] = PKW(P1, 2),  pw2); \
    VRD(6); SBAR(); GAPA(C1 = MFMA(kf[5], qr[2], C1),    P1[6], P1[7], P1[8], P1[9],     pw2[2] = PKW(P1, 4),  pw2[3] = PKW(P1, 6),  pw2); \
    VRD(3); SBAR(); GAPA(C0 = MFMA(kf[6], qr[3], C0),    P1[10], P1[11], P1[12], P1[13], pw3[0] = PKW(P1, 8),  pw3[1] = PKW(P1, 10), pw3); \
    VRD(7); SBAR(); GAPA(C1 = MFMA(kf[7], qr[3], C1),    P1[14], P1[15], 0.f, 0.f,       pw3[2] = PKW(P1, 12), pw3[3] = PKW(P1, 14), pw3); \
    l_reg += sacc; \
    if (GK) DMA_K((t) + 3, sl_cur); if (GV) DMA_V((t) + 1, sl_next); \
    if (MASK) cmask(C0, C1, (t) - (NT - 4), qrel, hi); \
    { const float rm = rowmax(C0, C1) - mhat; resc = false; \
      if (__builtin_expect(__any(rm > (float)THR), 0)) { const float dl = __builtin_fmaxf(rm, 0.f); mhat += dl; \
          const float f = __builtin_amdgcn_exp2f(-dl); l_reg *= f; if (hi == 0) wsf[r32] = f; resc = true; } } \
    const float nmh = -mhat; SBAR(); \
    GAPB(o[0] = MFMA(PAF(0), VFR(0), o[0]), C0, 0);              GAPB(o[1] = MFMA(PAF(0), VFR(4), o[1]), C0, 4); \
    KRD(GL, 0); GAPB(o[0] = MFMA(PAF(1), VFR(1), o[0]), C0, 8);  KRD(GL, 1); GAPB(o[1] = MFMA(PAF(1), VFR(5), o[1]), C0, 12); \
    KRD(GL, 2); GAPB(o[0] = MFMA(PAF(2), VFR(2), o[0]), C1, 0);  KRD(GL, 3); GAPB(o[1] = MFMA(PAF(2), VFR(6), o[1]), C1, 4); \
    GAPB(o[0] = MFMA(PAF(3), VFR(3), o[0]), C1, 8);              GAPB(o[1] = MFMA(PAF(3), VFR(7), o[1]), C1, 12); \
    if (GB) ldbias(P0, P1, bp0 + ((t) + 1) * 256); \
    } while (0)
    int t = 1;
    for (; t + 5 < NT; t += 2) {
        STEP(pB0, pB1, pA0, pA1, t, false, true, true, true, true);     WAIT_BAR(2); RESC(); ROT();
        STEP(pA0, pA1, pB0, pB1, t + 1, false, true, true, true, true); WAIT_BAR(2); RESC(); ROT();
    }
#define ENDW(tt) do { if ((tt) + 3 < NT) { WAIT_BAR(2); } else if ((tt) + 2 < NT) { WAIT_BAR(1); } else { WAIT_BAR(0); } } while (0)
    for (; t + 1 < NT; t += 2) {
        STEP(pB0, pB1, pA0, pA1, t, true, (t + 3 < NT), (t + 1 < NT), (t + 1 < NT), true);         ENDW(t);     RESC(); ROT();
        STEP(pA0, pA1, pB0, pB1, t + 1, true, (t + 4 < NT), (t + 2 < NT), (t + 2 < NT), (t + 2 < NT));     ENDW(t + 1); RESC(); ROT();
    }
    STEP(pB0, pB1, pA0, pA1, NT - 1, true, false, false, false, false); RESC();
    { float sacc = pB0[0] + pB0[1];
#pragma unroll
      for (int r = 2; r < 16; ++r) sacc += pB0[r];
#pragma unroll
      for (int r = 0; r < 16; ++r) sacc += pB1[r];
      l_reg += sacc;
      pw0 = (u32x4){PKW(pB0, 0), PKW(pB0, 2), PKW(pB0, 4), PKW(pB0, 6)}; pw1 = (u32x4){PKW(pB0, 8), PKW(pB0, 10), PKW(pB0, 12), PKW(pB0, 14)};
      pw2 = (u32x4){PKW(pB1, 0), PKW(pB1, 2), PKW(pB1, 4), PKW(pB1, 6)}; pw3 = (u32x4){PKW(pB1, 8), PKW(pB1, 10), PKW(pB1, 12), PKW(pB1, 14)};
      const lds_cptr vp_ = vp0 + sl_cur; _Pragma("unroll") for (int i = 0; i < 8; ++i) VRD(i);
      o[0] = MFMA(PAF(0), VFR(0), o[0]); o[1] = MFMA(PAF(0), VFR(4), o[1]); o[0] = MFMA(PAF(1), VFR(1), o[0]); o[1] = MFMA(PAF(1), VFR(5), o[1]);
      o[0] = MFMA(PAF(2), VFR(2), o[0]); o[1] = MFMA(PAF(2), VFR(6), o[1]); o[0] = MFMA(PAF(3), VFR(3), o[0]); o[1] = MFMA(PAF(3), VFR(7), o[1]); }
    { auto rr = __builtin_amdgcn_permlane32_swap(__float_as_uint(l_reg), __float_as_uint(l_reg), false, false); l_reg = __uint_as_float(rr[0]) + __uint_as_float(rr[1]); }
    if (hi == 0) wsf[32 + r32] = l_reg; asm volatile("s_waitcnt lgkmcnt(0)" ::: "memory");
    float rli[16];
#pragma unroll
    for (int r = 0; r < 16; ++r) rli[r] = __builtin_amdgcn_rcpf(wsf[32 + crow(r, hi)]);
    bf16* Ow = O + (long)(q0 + wid * QBLK) * DM; bf16* stg = (bf16*)(lds + LDS_OST) + wid * 2048;
#pragma unroll
    for (int r = 0; r < 16; r += 1) { const int orow = crow(r, hi);
#pragma unroll
        for (int d0 = 0; d0 < 2; ++d0) { const unsigned pk = cvtpk(o[d0][r] * rli[r], 0.f); stg[orow * 64 + d0 * 32 + r32] = (bf16)(pk & 0xffffu); } }
    asm volatile("s_waitcnt lgkmcnt(0)" ::: "memory");
#pragma unroll
    for (int i = 0; i < 4; ++i) { const int row = i * 8 + (lane >> 3), ch = lane & 7; *(u32x4*)(Ow + (long)row * DM + ch * 8) = *(const u32x4*)(stg + row * 64 + ch * 8); }
    asm volatile("s_waitcnt lgkmcnt(0)\n\ts_barrier" ::: "memory");
#undef DMA_K
#undef DMA_V
#undef ROT
#undef EX
#undef RESC
#undef PKW
#undef PAF
#undef VFR
#undef VRD
#undef KRD
#undef ENDW
#undef GAPA
#undef GAPB
#undef STEP
}
__device__ __forceinline__ void attn_unit2(const bf16* Q, const bf16* __restrict__ K, const bf16* __restrict__ V, bf16* O, int qb, int T0, char* lds) {
    int tid_ = threadIdx.x; asm volatile("" : "+v"(tid_));
    const int tid = tid_, lane = tid & 63, r32 = lane & 31, hi = lane >> 5; const int wid = __builtin_amdgcn_readfirstlane(tid >> 6);
    const int q0 = qb * QB, NT = (q0 + QB) / KVBLK - T0;
    const bf16* Qw = Q + (long)(q0 + wid * QBLK) * DM;
    const unsigned lds0 = (unsigned)(uintptr_t)lds; float* wsf = (float*)(lds + LDS2_WS) + wid * 64;
    const bf16* ksrc = K + (long)(T0 * KVBLK + lane) * DM + wid * 8;
    const bf16* vsrc = V + (long)(T0 * KVBLK + 16 * (wid & 3) + (lane >> 2)) * DM + (wid >> 2) * 32 + (lane & 3) * 8;
    const unsigned kdst = lds0 + LDS_K + wid * 1024, vdst = lds0 + LDS2_V + wid * 1024;
#define DMA_K(t, slot) glds16(ksrc + (long)(t) * KVBLK * DM, (unsigned)__builtin_amdgcn_readfirstlane(kdst + (slot)))
#define DMA_V(t, slot) do { glds16(vsrc + (long)(t) * KVBLK * DM, (unsigned)__builtin_amdgcn_readfirstlane(vdst + 2 * (slot))); glds16(vsrc + (long)(t) * KVBLK * DM + 64, (unsigned)__builtin_amdgcn_readfirstlane(vdst + 2 * (slot) + 8192)); } while (0)
    const lds_cptr vp0 = (lds_cptr)lds + LDS2_V + ((lane >> 4) & 1) * 32 + (lane & 3) * 8 + (4 * hi + ((lane & 15) >> 2)) * 64;
    const lds_cptr kp0 = (lds_cptr)lds + LDS_K + hi * 1024 + r32 * 16;
    const lds_cptr bp0 = (lds_cptr)lds + LDS2_BIAS + T0 * 256 + hi * 16;
    DMA_K(0, 0); DMA_V(0, 0); DMA_K(1, SLOTB);
    bf16x8 qr[4];
#pragma unroll
    for (int d0 = 0; d0 < 4; ++d0) qr[d0] = *reinterpret_cast<const bf16x8*>(&Qw[(long)r32 * DM + d0 * 16 + hi * 8]);
    const lds_cptr qp0 = (lds_cptr)lds + LDS2_Q + wid * 4096 + hi * 512 + r32 * 16;
#pragma unroll
    for (int d0 = 0; d0 < 4; ++d0) *(__attribute__((address_space(3))) bf16x8*)(qp0 + d0 * 1024) = qr[d0];
    float mhat = 0.f, l_reg = 0.f; f32x16 o[4]; o[0] = f32x16{}; o[1] = f32x16{}; o[2] = f32x16{}; o[3] = f32x16{};
    const int qrel = wid * QBLK + r32; bool resc = false;
    f32x16 pA0, pA1, pB0, pB1; s16x4 vl0, vh0, vl1, vh1; u32x4 pw0, pw1, pw2, pw3;
    int sl_prev = 0, sl_cur = 0, sl_next = SLOTB;
#define ROT() do { sl_prev = sl_cur; sl_cur = sl_next; sl_next = (sl_next == 2 * SLOTB) ? 0 : sl_next + SLOTB; } while (0)
#define EX(v) __builtin_amdgcn_exp2f((v) + nmh)
#define RESC() do { if (resc) { _Pragma("unroll") for (int d_ = 0; d_ < 4; ++d_) _Pragma("unroll") for (int r = 0; r < 16; ++r) o[d_][r] *= wsf[crow(r, hi)]; } } while (0)
    DMA_K(2, 2 * SLOTB);
    ldbias(pA0, pA1, bp0);
    WAIT_BAR(4);
    { bf16x8 kf[8];
    _Pragma("unroll") for (int d0 = 0; d0 < 4; ++d0) kload2(kf, kp0, d0);
    pA0 = MFMA(kf[0], qr[0], pA0); pA1 = MFMA(kf[1], qr[0], pA1); pA0 = MFMA(kf[2], qr[1], pA0); pA1 = MFMA(kf[3], qr[1], pA1);
    pA0 = MFMA(kf[4], qr[2], pA0); pA1 = MFMA(kf[5], qr[2], pA1); pA0 = MFMA(kf[6], qr[3], pA0); pA1 = MFMA(kf[7], qr[3], pA1); }
    if (NT == 4) cmask(pA0, pA1, 0, qrel, hi);
    { const float rm = rowmax(pA0, pA1); mhat = rm; const float nmh = -mhat;
#pragma unroll
      for (int r = 0; r < 16; ++r) { pA0[r] = EX(pA0[r]); pA1[r] = EX(pA1[r]); } }
    WAIT_BAR(0);
    DMA_V(1, SLOTB); ROT();
    WAIT_BAR(2);
#define PKW(P, i) cvtpk(P[i], P[i + 1])
#define PAF(k) __builtin_bit_cast(bf16x8, pw##k)
#define VOFF(i, hf) ((hf) * 8192 + ((i) >> 2) * 4096 + ((i) & 3) * 1024)
#define VLD(S, i, hf) do { vl##S = vtr(vp_ + VOFF(i, hf)); vh##S = vtr(vp_ + VOFF(i, hf) + 512); } while (0)
#define VF(S) (bf16x8){vl##S[0], vl##S[1], vl##S[2], vl##S[3], vh##S[0], vh##S[1], vh##S[2], vh##S[3]}
#define KRD(G, d0) do { if (G) { kload2(kf, kp0 + sl_next, d0); SBAR(); } } while (0)
#define GAPA(MF, a0, a1, a2, a3, W0, W1, PW) do { MF; sacc += a0; sacc += a1; sacc += a2; sacc += a3; W0; W1; PIN(PW); PIN(sacc); SBAR(); } while (0)
#define QLD(d0) (*(const __attribute__((address_space(3))) bf16x8*)(qp0 + (d0) * 1024))
#define GAPC(MF) do { MF; SBAR(); } while (0)
#define GAPB(MF, X, i) do { MF; X[i] = EX(X[i]); X[i + 1] = EX(X[i + 1]); X[i + 2] = EX(X[i + 2]); X[i + 3] = EX(X[i + 3]); PIN(X); SBAR(); } while (0)
#define STEP(C0, C1, P0, P1, t, MASK, GK, GV, GL, GB) do { SBAR(); \
    if (GK) DMA_K((t) + 2, sl_prev); \
    ldbias(C0, C1, bp0 + (t) * 256); \
    const lds_cptr vp_ = vp0 + 2 * sl_prev; \
    bf16x8 qa_ = QLD(0); float sacc = P0[0] + P0[1]; \
    { bf16x8 kf[8]; _Pragma("unroll") for (int d0_ = 0; d0_ < 4; ++d0_) kload2(kf, kp0 + sl_cur, d0_); \
    GAPA(C0 = MFMA(kf[0], qa_, C0), P0[2], P0[3], P0[4], P0[5],     pw0[0] = PKW(P0, 0),  pw0[1] = PKW(P0, 2),  pw0); \
    GAPA(C1 = MFMA(kf[1], qa_, C1), P0[6], P0[7], P0[8], P0[9],     pw0[2] = PKW(P0, 4),  pw0[3] = PKW(P0, 6),  pw0); \
    qa_ = QLD(1); SBAR(); \
    GAPA(C0 = MFMA(kf[2], qa_, C0),    P0[10], P0[11], P0[12], P0[13], pw1[0] = PKW(P0, 8),  pw1[1] = PKW(P0, 10), pw1); \
    GAPA(C1 = MFMA(kf[3], qa_, C1),    P0[14], P0[15], P1[0], P1[1],   pw1[2] = PKW(P0, 12), pw1[3] = PKW(P0, 14), pw1); \
    qa_ = QLD(2); SBAR(); \
    GAPA(C0 = MFMA(kf[4], qa_, C0),    P1[2], P1[3], P1[4], P1[5],     pw2[0] = PKW(P1, 0),  pw2[1] = PKW(P1, 2),  pw2); \
    GAPA(C1 = MFMA(kf[5], qa_, C1),    P1[6], P1[7], P1[8], P1[9],     pw2[2] = PKW(P1, 4),  pw2[3] = PKW(P1, 6),  pw2); \
    qa_ = QLD(3); SBAR(); \
    GAPA(C0 = MFMA(kf[6], qa_, C0),    P1[10], P1[11], P1[12], P1[13], pw3[0] = PKW(P1, 8),  pw3[1] = PKW(P1, 10), pw3); \
    GAPA(C1 = MFMA(kf[7], qa_, C1),    P1[14], P1[15], 0.f, 0.f,       pw3[2] = PKW(P1, 12), pw3[3] = PKW(P1, 14), pw3); } \
    l_reg += sacc; \
    if (GV) DMA_V((t) + 1, sl_next); \
    if (MASK) cmask(C0, C1, (t) - (NT - 4), qrel, hi); \
    { const float rm = rowmax(C0, C1) - mhat; resc = false; \
      if (__builtin_expect(__any(rm > (float)THR), 0)) { const float dl = __builtin_fmaxf(rm, 0.f); mhat += dl; \
          const float f = __builtin_amdgcn_exp2f(-dl); l_reg *= f; if (hi == 0) wsf[r32] = f; resc = true; } } \
    const float nmh = -mhat; SBAR(); \
    VLD(0, 0, 0); SBAR(); \
    GAPB(o[0] = MFMA(PAF(0), VF(0), o[0]), C0, 0);  VLD(1, 4, 0); SBAR(); \
    GAPB(o[1] = MFMA(PAF(0), VF(1), o[1]), C0, 4);  VLD(0, 1, 0); SBAR(); \
    GAPB(o[0] = MFMA(PAF(1), VF(0), o[0]), C0, 8);  VLD(1, 5, 0); SBAR(); \
    GAPB(o[1] = MFMA(PAF(1), VF(1), o[1]), C0, 12);  VLD(0, 2, 0); SBAR(); \
    GAPB(o[0] = MFMA(PAF(2), VF(0), o[0]), C1, 0);  VLD(1, 6, 0); SBAR(); \
    GAPB(o[1] = MFMA(PAF(2), VF(1), o[1]), C1, 4);  VLD(0, 3, 0); SBAR(); \
    GAPB(o[0] = MFMA(PAF(3), VF(0), o[0]), C1, 8);  VLD(1, 7, 0); SBAR(); \
    GAPB(o[1] = MFMA(PAF(3), VF(1), o[1]), C1, 12);  VLD(0, 0, 1); SBAR(); \
    GAPC(o[2] = MFMA(PAF(0), VF(0), o[2]));  VLD(1, 4, 1); SBAR(); \
    GAPC(o[3] = MFMA(PAF(0), VF(1), o[3]));  VLD(0, 1, 1); SBAR(); \
    GAPC(o[2] = MFMA(PAF(1), VF(0), o[2]));  VLD(1, 5, 1); SBAR(); \
    GAPC(o[3] = MFMA(PAF(1), VF(1), o[3]));  VLD(0, 2, 1); SBAR(); \
    GAPC(o[2] = MFMA(PAF(2), VF(0), o[2]));  VLD(1, 6, 1); SBAR(); \
    GAPC(o[3] = MFMA(PAF(2), VF(1), o[3]));  VLD(0, 3, 1); SBAR(); \
    GAPC(o[2] = MFMA(PAF(3), VF(0), o[2]));  VLD(1, 7, 1); SBAR(); \
    GAPC(o[3] = MFMA(PAF(3), VF(1), o[3]));  \
    } while (0)
    int t = 1;
    for (; t + 5 < NT; t += 2) {
        STEP(pB0, pB1, pA0, pA1, t, false, true, true, true, true);     WAIT_BAR(3); RESC(); ROT();
        STEP(pA0, pA1, pB0, pB1, t + 1, false, true, true, true, true); WAIT_BAR(3); RESC(); ROT();
    }
#define ENDW(tt) do { if ((tt) + 2 < NT) { WAIT_BAR(3); } else { WAIT_BAR(0); } } while (0)
    for (; t + 1 < NT; t += 2) {
        STEP(pB0, pB1, pA0, pA1, t, true, (t + 2 < NT), (t + 1 < NT), (t + 1 < NT), true);         ENDW(t);     RESC(); ROT();
        STEP(pA0, pA1, pB0, pB1, t + 1, true, (t + 3 < NT), (t + 2 < NT), (t + 2 < NT), (t + 2 < NT));     ENDW(t + 1); RESC(); ROT();
    }
    STEP(pB0, pB1, pA0, pA1, NT - 1, true, false, false, false, false); RESC();
    { float sacc = pB0[0] + pB0[1];
#pragma unroll
      for (int r = 2; r < 16; ++r) sacc += pB0[r];
#pragma unroll
      for (int r = 0; r < 16; ++r) sacc += pB1[r];
      l_reg += sacc;
      pw0 = (u32x4){PKW(pB0, 0), PKW(pB0, 2), PKW(pB0, 4), PKW(pB0, 6)}; pw1 = (u32x4){PKW(pB0, 8), PKW(pB0, 10), PKW(pB0, 12), PKW(pB0, 14)};
      pw2 = (u32x4){PKW(pB1, 0), PKW(pB1, 2), PKW(pB1, 4), PKW(pB1, 6)}; pw3 = (u32x4){PKW(pB1, 8), PKW(pB1, 10), PKW(pB1, 12), PKW(pB1, 14)};
      const lds_cptr vp_ = vp0 + 2 * sl_cur;
#pragma unroll
      for (int hf = 0; hf < 2; ++hf) { s16x4 dl[8], dh[8];
#pragma unroll
          for (int i = 0; i < 8; ++i) { dl[i] = vtr(vp_ + VOFF(i, hf)); dh[i] = vtr(vp_ + VOFF(i, hf) + 512); }
#define DF(i) (bf16x8){dl[i][0], dl[i][1], dl[i][2], dl[i][3], dh[i][0], dh[i][1], dh[i][2], dh[i][3]}
          o[2 * hf] = MFMA(PAF(0), DF(0), o[2 * hf]); o[2 * hf + 1] = MFMA(PAF(0), DF(4), o[2 * hf + 1]); o[2 * hf] = MFMA(PAF(1), DF(1), o[2 * hf]); o[2 * hf + 1] = MFMA(PAF(1), DF(5), o[2 * hf + 1]);
          o[2 * hf] = MFMA(PAF(2), DF(2), o[2 * hf]); o[2 * hf + 1] = MFMA(PAF(2), DF(6), o[2 * hf + 1]); o[2 * hf] = MFMA(PAF(3), DF(3), o[2 * hf]); o[2 * hf + 1] = MFMA(PAF(3), DF(7), o[2 * hf + 1]);
#undef DF
      } }
    { auto rr = __builtin_amdgcn_permlane32_swap(__float_as_uint(l_reg), __float_as_uint(l_reg), false, false); l_reg = __uint_as_float(rr[0]) + __uint_as_float(rr[1]); }
    if (hi == 0) wsf[32 + r32] = l_reg; asm volatile("s_waitcnt lgkmcnt(0)" ::: "memory");
    float rli[16];
#pragma unroll
    for (int r = 0; r < 16; ++r) rli[r] = __builtin_amdgcn_rcpf(wsf[32 + crow(r, hi)]);
    bf16* Ow = O + (long)(q0 + wid * QBLK) * DM; bf16* stg = (bf16*)(lds + LDS2_OST) + wid * 2048;
#pragma unroll
    for (int hf = 0; hf < 2; ++hf) {
#pragma unroll
        for (int r = 0; r < 16; r += 1) { const int orow = crow(r, hi);
#pragma unroll
            for (int d0 = 0; d0 < 2; ++d0) { const unsigned pk = cvtpk(o[2 * hf + d0][r] * rli[r], 0.f); stg[orow * 64 + d0 * 32 + r32] = (bf16)(pk & 0xffffu); } }
        asm volatile("s_waitcnt lgkmcnt(0)" ::: "memory");
#pragma unroll
        for (int i = 0; i < 4; ++i) { const int row = i * 8 + (lane >> 3), ch = lane & 7; *(u32x4*)(Ow + (long)row * DM + 64 * hf + ch * 8) = *(const u32x4*)(stg + row * 64 + ch * 8); }
        asm volatile("s_waitcnt lgkmcnt(0)" ::: "memory"); }
    asm volatile("s_waitcnt lgkmcnt(0)\n\ts_barrier" ::: "memory");
#undef DMA_K
#undef DMA_V
#undef ROT
#undef EX
#undef RESC
#undef PKW
#undef PAF
#undef VF
#undef VLD
#undef VOFF
#undef KRD
#undef ENDW
#undef GAPA
#undef GAPB
#undef GAPC
#undef QLD
#undef STEP
}
#undef SBAR
#undef PIN
#undef MFMA
#undef WAIT_BAR
#undef MX3
}
#define GAS __attribute__((address_space(1)))
#define LAS __attribute__((address_space(3)))
typedef unsigned short bf16;
typedef unsigned v4u __attribute__((ext_vector_type(4)));
typedef unsigned v2u __attribute__((ext_vector_type(2)));
typedef float f32x4 __attribute__((ext_vector_type(4)));
typedef short bf16x8 __attribute__((ext_vector_type(8)));
typedef short v4i16 __attribute__((ext_vector_type(4)));
using pg8::pkbf; using pg8::bflo; using pg8::bfhi; using pg8::row_rstd; using pg8::sigmoidf_;

constexpr int NWAVES = 8;
constexpr int BATCH = 8, SEQ = 2048, D = 1024, FF = 2816, M = BATCH * SEQ, NIN = 7176, DEPTH = 2;
constexpr float LOG2E = 1.4426950408889634f;
constexpr float C2 = 0.125f * LOG2E;
constexpr size_t MiB = 1u << 20;
constexpr size_t WS_CTL = 0;
constexpr size_t WS_W1 = 1 * MiB;
constexpr size_t WS_W2 = WS_W1 + 11 * MiB;
constexpr size_t WS_W3 = WS_W2 + 11 * MiB / 2;
constexpr size_t WS_W4 = WS_W3 + 11 * MiB;
constexpr size_t WS_WIN = WS_W4 + 11 * MiB / 2;
constexpr size_t WS_WBR = WS_WIN + 14 * MiB;
constexpr size_t WS_WO = WS_WBR + 3 * MiB;
constexpr size_t WS_WQKV = WS_WO + 2 * MiB;
constexpr size_t WS_UVF = WS_WQKV + 384 * 1024;
constexpr size_t WS_WFFT = WS_UVF + 32 * 1024;
constexpr size_t WS_RS = WS_WFFT + 64 * 1024;
constexpr size_t WS_FFB = WS_RS + 1 * MiB;
constexpr size_t WS_LIFP = WS_FFB + MiB / 2;
constexpr size_t WS_LIF = WS_LIFP, WS_CS = WS_LIFP + 512 * 1024, WS_MP = WS_CS + 4096, WS_NV = WS_LIFP + 768 * 1024, WS_NP = WS_LIFP + 1024 * 1024;
constexpr size_t WS_XB = 58 * MiB;
constexpr size_t WS_SLOT = 90 * MiB;
constexpr size_t SLOT_BYTES = SLOT_STRIDE_E * 2, SLOT_ELEMS = SLOT_STRIDE_E;
constexpr size_t WS_END = WS_SLOT + 11 * SLOT_BYTES;
static_assert(WS_LIFP + 2 * MiB <= WS_XB, "ws map");
enum { S_DQ = 0, S_FQ = 1, S_DK = 2, S_MX = 3, S_MZ = 4, S_DV = 5, S_FK = 6, S_FV = 7, S_A1 = 8, S_A2 = 9, S_MQ = 5, S_MK = 6, S_MV = 2, S_CP = 8, S_G0 = 5, S_MG = 3 };
constexpr int XB_LDS_OFF = 155648 - 64;
constexpr int RING_BYTES = 131072, LDS_BYTES = 155648;

#define LDS_WAIT() asm volatile("s_waitcnt lgkmcnt(0)" ::: "memory")
#define VM_WAIT() asm volatile("s_waitcnt vmcnt(0)" ::: "memory")
__device__ __forceinline__ float wave_sum(float v) {
#pragma unroll
    for (int o = 1; o < 64; o <<= 1) v += __shfl_xor(v, o);
    return v;
}
__device__ __forceinline__ float log_sigmoid_f(float x) { return fminf(x, 0.f) - __logf(1.0f + __expf(-fabsf(x))); }
__device__ __forceinline__ float silu_f(float x) { return x * __builtin_amdgcn_rcpf(1.0f + __expf(-x)); }

struct Frame {
    LAS unsigned char* lds; char* ldsg;
    int tid, wave, vcu, G, vbx;
    const float* const* in;
};

template <bool SCALED>
__device__ __forceinline__ void tr_item(const float* src, int ldsrc, int scol0, const float* scale, bf16* dst, int Kd, int drow0, int k0, LAS float* scr, int lane) {
    float v[32], sc[32];
#pragma unroll
    for (int i = 0; i < 32; ++i) { const int kk = 2 * i + (lane >> 5); v[i] = src[(size_t)(k0 + kk) * ldsrc + scol0 + (lane & 31)]; sc[i] = SCALED ? scale[k0 + kk] : 1.0f; }
#pragma unroll
    for (int i = 0; i < 32; ++i) { const int kk = 2 * i + (lane >> 5); scr[kk * 33 + (lane & 31)] = SCALED ? v[i] * sc[i] : v[i]; }
    LDS_WAIT(); asm volatile("" ::: "memory");
    const int c = lane & 7;
#pragma unroll
    for (int j = 0; j < 4; ++j) { const int n = (lane >> 3) + 8 * j; const LAS float* s = scr + (8 * c) * 33 + n;
        v4u o; o.x = pkbf(s[0 * 33], s[1 * 33]); o.y = pkbf(s[2 * 33], s[3 * 33]); o.z = pkbf(s[4 * 33], s[5 * 33]); o.w = pkbf(s[6 * 33], s[7 * 33]);
        *(v4u*)(dst + (size_t)(drow0 + n) * Kd + k0 + 8 * c) = o; }
    LDS_WAIT(); asm volatile("" ::: "memory");
}
struct Args { const float* in[32]; float* out; unsigned char* ws; int ph_lo, ph_hi; };
typedef __attribute__((address_space(4))) const Args* KArgs;
__device__ __forceinline__ bf16* slotp(unsigned char* ws, int s) { return (bf16*)(ws + WS_SLOT + (size_t)s * SLOT_BYTES); }
__device__ __forceinline__ f32x4 mfma16(bf16x8 a, bf16x8 b, f32x4 c) { return __builtin_amdgcn_mfma_f32_16x16x32_bf16(a, b, c, 0, 0, 0); }
__device__ __forceinline__ v4i16 trd(const LAS bf16* p) { return __builtin_amdgcn_ds_read_tr16_b64_v4i16((LAS v4i16*)p); }
__device__ __forceinline__ bf16x8 tr2(const LAS bf16* base, int r0, int c0, int stride, int lane) {
    const int i = lane & 15, q = i >> 2, p = i & 3; const LAS bf16* a = base + (r0 + q) * stride + c0 + 4 * p;
    const v4i16 lo = trd(a), hi = trd(a + 4 * stride);
    return (bf16x8){lo[0], lo[1], lo[2], lo[3], hi[0], hi[1], hi[2], hi[3]};
}
__device__ __forceinline__ void unpack8(const v4u w, float* x) { x[0] = bflo(w.x); x[1] = bfhi(w.x); x[2] = bflo(w.y); x[3] = bfhi(w.y); x[4] = bflo(w.z); x[5] = bfhi(w.z); x[6] = bflo(w.w); x[7] = bfhi(w.w); }
__device__ __forceinline__ v4u pack8(const float* x) { v4u o; o.x = pkbf(x[0], x[1]); o.y = pkbf(x[2], x[3]); o.z = pkbf(x[4], x[5]); o.w = pkbf(x[6], x[7]); return o; }

__device__ __forceinline__ void phase_prep(Frame& F, KArgs a, int l, int groups, int gw, int NGW) {
    unsigned char* ws = a->ws;
    LAS float* scr = (LAS float*)(F.lds + F.wave * 16384);
    const int lane = (F.tid & 63);
    bf16* W1 = (bf16*)(ws + WS_W1); bf16* W2 = (bf16*)(ws + WS_W2); bf16* W3 = (bf16*)(ws + WS_W3); bf16* W4 = (bf16*)(ws + WS_W4);
    bf16* WIN = (bf16*)(ws + WS_WIN); bf16* WBR = (bf16*)(ws + WS_WBR); bf16* WO = (bf16*)(ws + WS_WO); bf16* WQKV = (bf16*)(ws + WS_WQKV);
    constexpr int I_UP = 16 * 176, I_DN = 44 * 32, I_IN = 16 * 224, I_BR = 3 * 8 * 32, I_O = 16 * 32, I_QKV = 12 * 8;
    constexpr int NITEMS = 2 * I_UP + 2 * I_DN + I_IN + I_BR + I_O + I_QKV;
    for (int it = gw; it < NITEMS; it += NGW) {
        int r = it;
        if (r < 2 * (I_UP + I_DN)) {
            const int f2 = r >= (I_UP + I_DN); if (f2) r -= (I_UP + I_DN);
            if (!(groups & (f2 ? 2 : (r < I_UP ? 1 : 16)))) continue;
            const float* nrm = a->in[f2 ? 27 : 1] + (size_t)l * D; const float* wg = a->in[f2 ? 28 : 2] + (size_t)l * D * FF; const float* wu = a->in[f2 ? 29 : 3] + (size_t)l * D * FF; const float* wd = a->in[f2 ? 30 : 4] + (size_t)l * D * FF;
            if (r < I_UP) { const int kb = r / 176, nb = r % 176, n0 = 32 * nb, pn = n0 >> 8, j = n0 & 255;
                tr_item<true>(j < 128 ? wg : wu, FF, 128 * pn + (j & 127), nrm, f2 ? W3 : W1, D, n0, 64 * kb, scr, lane); }
            else { r -= I_UP; const int kb = r / 32, nb = r % 32; tr_item<false>(wd, D, 32 * nb, nullptr, f2 ? W4 : W2, FF, 32 * nb, 64 * kb, scr, lane); }
            continue; }
        r -= 2 * (I_UP + I_DN);
        if (!(groups & 4)) continue;
        if (r < I_IN) { const int kb = r / 224, nb = r % 224, n0 = 32 * nb; tr_item<true>(a->in[6] + (size_t)l * D * NIN, NIN, n0 < 3072 ? n0 : n0 + 8, a->in[5] + (size_t)l * D, WIN, D, n0, 64 * kb, scr, lane); continue; }
        r -= I_IN;
        if (r < I_BR) { const int z = r / 256, rr = r % 256, kb = rr / 32, nb = rr % 32;
            const float* src = (z == 0 ? a->in[23] : (z == 1 ? a->in[24] : a->in[25])) + (size_t)l * 512 * D;
            tr_item<false>(src, D, 32 * nb, nullptr, WBR + (size_t)z * D * 512, 512, 32 * nb, 64 * kb, scr, lane); continue; }
        r -= I_BR;
        if (r < I_O) { const int kb = r / 32, nb = r % 32; tr_item<false>(a->in[26] + (size_t)l * D * D, D, 32 * nb, nullptr, WO, D, 32 * nb, 64 * kb, scr, lane); continue; }
        r -= I_O;
        { const int mh = r >> 3, rr = r & 7, mt = mh >> 2, hh = mh & 3, kb = rr >> 2, nb = rr & 3;
          const float* src = (mt == 0 ? a->in[16] : (mt == 1 ? a->in[17] : a->in[18])) + (size_t)(l * 4 + hh) * 128 * 128;
          tr_item<false>(src, 128, 32 * nb, nullptr, WQKV + (size_t)mh * 16384, 128, 32 * nb, 64 * kb, scr, lane); }
    }
    if (groups & 4) { float* UVF = (float*)(ws + WS_UVF); const float* wq = a->in[16] + (size_t)l * 4 * 16384; const float* wk = a->in[17] + (size_t)l * 4 * 16384; const float* wv = a->in[18] + (size_t)l * 4 * 16384; const float* wif = a->in[19] + (size_t)l * 1536 * 8;
      for (int it = gw; it < 512; it += NGW) { const int hh = it >> 7, d = it & 127;
          const float* q = wq + (size_t)(hh * 128 + d) * 128; const float* k = wk + (size_t)(hh * 128 + d) * 128; const float* v = wv + (size_t)(hh * 128 + d) * 128;
          float U[8], V[8];
#pragma unroll
          for (int g = 0; g < 8; ++g) { U[g] = 0.f; V[g] = 0.f; }
#pragma unroll
          for (int eh = 0; eh < 2; ++eh) { const int e = lane + 64 * eh; const float qe = q[e], ke = k[e], ve = v[e];
              const f32x4* wqp = (const f32x4*)(wif + (size_t)(hh * 128 + e) * 8); const f32x4* wkp = (const f32x4*)(wif + (size_t)(512 + hh * 128 + e) * 8); const f32x4* wvp = (const f32x4*)(wif + (size_t)(1024 + hh * 128 + e) * 8);
#pragma unroll
              for (int c4 = 0; c4 < 2; ++c4) { const f32x4 a4 = wqp[c4], b4 = wkp[c4], c4v = wvp[c4];
#pragma unroll
                  for (int i = 0; i < 4; ++i) { U[4 * c4 + i] += qe * a4[i] + ke * b4[i]; V[4 * c4 + i] += ve * c4v[i]; } } }
#pragma unroll
          for (int g = 0; g < 8; ++g) { const float us = wave_sum(U[g]), vs = wave_sum(V[g]);
              if (lane == 0) { UVF[(size_t)((g & 3) * 4 + (g >> 2)) * 512 + hh * 128 + d] = us; UVF[(size_t)((g & 3) * 4 + 2 + (g >> 2)) * 512 + hh * 128 + d] = vs; } } }
      bf16* WFFT = (bf16*)(ws + WS_WFFT); const float* win = a->in[6] + (size_t)l * D * NIN; const float* nrm = a->in[5] + (size_t)l * D;
      for (int i = gw * 64 + lane; i < 8192; i += NGW * 64) { const int k = i >> 3, g = i & 7; const float w = nrm[k] * win[(size_t)k * NIN + 3072 + g];
          const unsigned wh = pkbf(w, 0.f) & 0xffffu, wl = pkbf(w - bflo(wh), 0.f) & 0xffffu; WFFT[g * 1024 + k] = (bf16)wh; WFFT[(8 + g) * 1024 + k] = (bf16)wl; }
    }
    if (groups & 8) {
        const float* x = a->in[0]; bf16* XB = (bf16*)(ws + WS_XB); float* RS = (float*)(ws + WS_RS);
        for (int m = gw; m < M; m += NGW) { const f32x4* xr = (const f32x4*)(x + (size_t)m * D) + lane; float s = 0.f; v2u* o8 = (v2u*)(XB + (size_t)m * D) + lane;
#pragma unroll
            for (int j = 0; j < 4; ++j) { const f32x4 v = xr[64 * j]; s += (v[0] * v[0] + v[1] * v[1]) + (v[2] * v[2] + v[3] * v[3]); v2u w; w.x = pkbf(v[0], v[1]); w.y = pkbf(v[2], v[3]); o8[64 * j] = w; }
            s = wave_sum(s);
            if (lane < 16) RS[(size_t)m * 16 + lane] = (lane == 0) ? s : 0.f; }
    }
}

__device__ __forceinline__ void job_ff(Frame& F, unsigned char* ws) {
    const bf16* WFFT = (const bf16*)(ws + WS_WFFT); const bf16* XB = (const bf16*)(ws + WS_XB); const float* RS = (const float*)(ws + WS_RS); float* FFB = (float*)(ws + WS_FFB);
    const int gw = F.vcu * NWAVES + F.wave, NGW = F.G * NWAVES, lane = (F.tid & 63), g = lane >> 4, li = lane & 15;
    for (int blk = (F.wave < 4 ? (F.vcu >> 5) * 128 + ((F.vcu & 31) & 7) * 16 + ((F.vcu & 31) >> 3) * 4 + F.wave : M / 16); blk < M / 16; blk += M / 16) {     const int r0 = 16 * blk;     f32x4 acc = {0.f, 0.f, 0.f, 0.f};
        const bf16* ap = XB + (size_t)(r0 + li) * D + 8 * g; const bf16* bp = WFFT + (size_t)li * D + 8 * g;
#pragma unroll
        for (int hf = 0; hf < 2; ++hf) { bf16x8 A[16], B[16];
#pragma unroll
            for (int ks = 0; ks < 16; ++ks) { A[ks] = *(const bf16x8*)(ap + 32 * (16 * hf + ks)); B[ks] = *(const bf16x8*)(bp + 32 * (16 * hf + ks)); }
#pragma unroll
            for (int ks = 0; ks < 16; ++ks) acc = mfma16(A[ks], B[ks], acc); }
#pragma unroll
        for (int r = 0; r < 4; ++r) { const float v = acc[r] + __shfl_xor(acc[r], 8); const int row = r0 + 4 * g + r; if ((lane & 8) == 0) FFB[(size_t)row * 8 + (lane & 7)] = v * row_rstd(RS, row); } }
}

__device__ __forceinline__ void phase_attn(Frame& F, KArgs a, int l, bool diff_only) {
    unsigned char* ws = a->ws; char* lds = F.ldsg;
    const float* FFB = (const float*)(ws + WS_FFB);
    for (int p = F.vcu; p < 512; p += F.G) {
        int tid = F.tid; asm volatile("" : "+v"(tid)); const int lane = tid & 63;
        int wave = F.wave; asm volatile("" : "+s"(wave));
        const bool diff = p < 256; if (diff_only && !diff) continue;
        const int idx = p & 255, bvh = idx >> 2, s = idx & 3, b = bvh >> 3, vh = bvh & 7; const size_t rowoff = (size_t)b * SEQ * 512;
        if (diff) { const int h = vh >> 1, mp = vh & 1; float* table = (float*)(lds + attn::LDS2_BIAS);
            const bf16* Q = slotp(ws, S_DQ) + rowoff + h * 128 + mp * 64; const bf16* K = slotp(ws, S_DK) + rowoff + h * 128 + mp * 64; const bf16* V = slotp(ws, S_DV) + rowoff + h * 128; bf16* O = slotp(ws, mp ? S_A2 : S_A1) + rowoff + h * 128;
            const float sl = exp2f(-2.0f * (float)(h + 1)) * LOG2E;
#pragma unroll
            for (int i = 0; i < 4; ++i) table[4 * tid + i] = sl * (float)(4 * tid + i);
            asm volatile("s_waitcnt lgkmcnt(0)\n\ts_barrier" ::: "memory");
#pragma unroll 1
            for (int rep = 0; rep < 2; ++rep) attn::attn_unit2(Q, K, V, O, rep ? 7 - s : s, 0, lds);
        } else { const int h = vh; float* table = (float*)(lds + attn::LDS_BIAS); float* wsum = (float*)(lds + attn::LDS_WS);
            const bf16* Q = slotp(ws, S_FQ) + rowoff + h * 64; const bf16* K = slotp(ws, S_FK) + rowoff + h * 64; const bf16* V = slotp(ws, S_FV) + rowoff + h * 64; bf16* O = slotp(ws, S_FQ) + rowoff + h * 64;
            const float bf = a->in[13][l * 8 + h]; float c[4]; float run = 0.f;
#pragma unroll
            for (int i = 0; i < 4; ++i) { run += log_sigmoid_f(FFB[((size_t)b * SEQ + 4 * tid + i) * 8 + h] + bf); c[i] = run; }
            float v = run;
#pragma unroll
            for (int o = 1; o < 64; o <<= 1) { const float t = __int_as_float(__builtin_amdgcn_ds_bpermute(((lane >= o) ? lane - o : lane) << 2, __float_as_int(v))); if (lane >= o) v += t; }
            if (lane == 63) wsum[wave] = v;
            asm volatile("s_waitcnt lgkmcnt(0)\n\ts_barrier" ::: "memory");
            float base = v - run;
#pragma unroll
            for (int w = 0; w < 8; ++w) if (w < wave) base += wsum[w];
#pragma unroll
            for (int i = 0; i < 4; ++i) table[4 * tid + i] = -(base + c[i]) * LOG2E;
            asm volatile("s_waitcnt lgkmcnt(0)\n\ts_barrier" ::: "memory");
#pragma unroll 1
            for (int rep = 0; rep < 2; ++rep) attn::attn_unit(Q, K, V, O, rep ? 7 - s : s, 0, lds);
        }
    }
}
__device__ __forceinline__ void job_diff_combine(Frame& F, KArgs a, int l) {
    unsigned char* ws = a->ws; const int gw = F.vcu * NWAVES + F.wave, NGW = F.G * NWAVES, lane = (F.tid & 63);
    const bf16* A1 = slotp(ws, S_A1); const bf16* A2 = slotp(ws, S_A2); bf16* OD = slotp(ws, S_DQ);
    const float lam_init = 0.8f - 0.6f * expf(-0.3f * (float)l);
    const float s1 = wave_sum(a->in[8][l * 64 + lane] * a->in[9][l * 64 + lane]), s2 = wave_sum(a->in[10][l * 64 + lane] * a->in[11][l * 64 + lane]);
    const float lam = expf(s1) - expf(s2) + lam_init, osc = 1.0f - lam_init;
    float sw[8];
#pragma unroll
    for (int i = 0; i < 8; ++i) sw[i] = a->in[12][l * 128 + ((8 * lane) & 127) + i] * osc;
    for (int m = (F.vcu >> 5) * SEQ + (F.vcu & 31) * NWAVES + F.wave, me = ((F.vcu >> 5) + 1) * SEQ; m < me; m += 32 * NWAVES) {
        const v4u w1 = *((const v4u*)(A1 + (size_t)m * 512) + lane), w2 = *((const v4u*)(A2 + (size_t)m * 512) + lane);
        float x1[8], x2[8], d[8]; unpack8(w1, x1); unpack8(w2, x2); float ss = 0.f;
#pragma unroll
        for (int i = 0; i < 8; ++i) { d[i] = x1[i] - lam * x2[i]; ss += d[i] * d[i]; }
        ss += __shfl_xor(ss, 1); ss += __shfl_xor(ss, 2); ss += __shfl_xor(ss, 4); ss += __shfl_xor(ss, 8);
        const float rstd = 1.0f / sqrtf(ss * (1.0f / 128.0f) + 1e-6f);
#pragma unroll
        for (int i = 0; i < 8; ++i) d[i] = d[i] * rstd * sw[i];
        *((v4u*)(OD + (size_t)m * 512) + lane) = pack8(d);
    }
}

#define LBAR() asm volatile("s_waitcnt lgkmcnt(0)\n\ts_barrier" ::: "memory")
constexpr int TS = 136;
__device__ __forceinline__ bf16* kv_ptr(unsigned char* ws, int u) { return slotp(ws, 7) + (size_t)u * 16384; }
__device__ __forceinline__ void conv_block(const bf16* MX, const float* cw, const float* cb, int r0, int pos0, int c0, int t0, float (&xc)[4][8], float (&xm)[4][8]) {
    float x[7][8]; v4u raw[7];
#pragma unroll
    for (int k = 0; k < 7; ++k) { const int t = t0 - 3 + k; const bool ok = (pos0 + t >= 0); raw[k] = *(const v4u*)(MX + (size_t)(r0 + (ok ? t : 0)) * 512 + c0); }
    __builtin_amdgcn_sched_barrier(0);
#pragma unroll
    for (int k = 0; k < 7; ++k) { const int t = t0 - 3 + k; const bool ok = (pos0 + t >= 0); v4u r = raw[k]; if (!ok) r = (v4u){0u, 0u, 0u, 0u}; unpack8(r, x[k]); }
#pragma unroll
    for (int i = 0; i < 8; ++i) { const float b = cb[c0 + i], w0 = cw[c0 + i], w1 = cw[512 + c0 + i], w2 = cw[1024 + c0 + i], w3 = cw[1536 + c0 + i];
#pragma unroll
        for (int tt = 0; tt < 4; ++tt) { xc[tt][i] = silu_f(b + w0 * x[tt][i] + w1 * x[tt + 1][i] + w2 * x[tt + 2][i] + w3 * x[tt + 3][i]); xm[tt][i] = x[tt + 3][i]; } }
}
__device__ __forceinline__ void job_gates(Frame& F, KArgs a, int l) {
    unsigned char* ws = a->ws; const int tid = F.tid, lane = tid & 63, w = F.wave, li = lane & 15, g = lane >> 4;
    const bf16* MX = slotp(ws, S_MX); const float* UVF = (const float*)(ws + WS_UVF); float* LIF = (float*)(ws + WS_LIF);
    const float* cw = a->in[14] + (size_t)l * 4 * 512; const float* cb = a->in[15] + (size_t)l * 512;
    const int R0 = (F.vcu >> 5) * SEQ + (F.vcu & 31) * 64;
    LAS float* part = (LAS float*)F.lds;
    bf16x8 BU[2], BV[2];
    { const int gt = li & 7, ru = (gt & 3) * 4 + (gt >> 2);
#pragma unroll
      for (int ks = 0; ks < 2; ++ks) { const float* pu = UVF + (size_t)ru * 512 + 64 * w + 32 * ks + 8 * g; const float* pv = pu + 1024;
          const f32x4 u0 = *(const f32x4*)pu, u1 = *(const f32x4*)(pu + 4), v0 = *(const f32x4*)pv, v1 = *(const f32x4*)(pv + 4);
          float uu[8] = {u0[0], u0[1], u0[2], u0[3], u1[0], u1[1], u1[2], u1[3]}, vv[8] = {v0[0], v0[1], v0[2], v0[3], v1[0], v1[1], v1[2], v1[3]};
          if (li >= 8) {
#pragma unroll
              for (int i = 0; i < 8; ++i) { uu[i] -= bflo(pkbf(uu[i], 0.f)); vv[i] -= bflo(pkbf(vv[i], 0.f)); } }
          BU[ks] = __builtin_bit_cast(bf16x8, pack8(uu)); BV[ks] = __builtin_bit_cast(bf16x8, pack8(vv)); } }
    float wj[2][4][8], bb[2][8];
#pragma unroll
    for (int ks = 0; ks < 2; ++ks) { const int c0 = 64 * w + 32 * ks + 8 * g;
#pragma unroll
        for (int i = 0; i < 8; ++i) { bb[ks][i] = cb[c0 + i];
#pragma unroll
            for (int j = 0; j < 4; ++j) wj[ks][j][i] = cw[j * 512 + c0 + i]; } }
#pragma unroll 2
    for (int T = 0; T < 4; ++T) { const int m = R0 + 16 * T + li, pos = m & (SEQ - 1); f32x4 acc = {0.f, 0.f, 0.f, 0.f};
        v4u raw[2][4];
#pragma unroll
        for (int ks = 0; ks < 2; ++ks)
#pragma unroll
            for (int j = 0; j < 4; ++j) { const bool ok = (pos - 3 + j >= 0); raw[ks][j] = *(const v4u*)(MX + (size_t)(m - (ok ? 3 - j : 0)) * 512 + 64 * w + 32 * ks + 8 * g); if (!ok) raw[ks][j] = (v4u){0u, 0u, 0u, 0u}; }
#pragma unroll
        for (int ks = 0; ks < 2; ++ks) { float x[4][8], xc[8];
#pragma unroll
            for (int j = 0; j < 4; ++j) unpack8(raw[ks][j], x[j]);
#pragma unroll
            for (int i = 0; i < 8; ++i) xc[i] = silu_f(bb[ks][i] + wj[ks][0][i] * x[0][i] + wj[ks][1][i] * x[1][i] + wj[ks][2][i] * x[2][i] + wj[ks][3][i] * x[3][i]);
            acc = mfma16(__builtin_bit_cast(bf16x8, pack8(xc)), BU[ks], acc); acc = mfma16(__builtin_bit_cast(bf16x8, raw[ks][3]), BV[ks], acc); }
#pragma unroll
        for (int r = 0; r < 4; ++r) { const float v = acc[r] + __shfl_xor(acc[r], 8); if ((lane & 8) == 0) part[((w * 4 + T) * 16 + 4 * g + r) * 8 + (lane & 7)] = v; } }
    __syncthreads();
    { const int row = tid >> 3, gt = tid & 7; float s = a->in[20][l * 8 + gt];
#pragma unroll
      for (int ww = 0; ww < 8; ++ww) s += part[((ww * 4 + (row >> 4)) * 16 + (row & 15)) * 8 + gt];
      LIF[((size_t)(R0 + row) * 4 + (gt & 3)) * 2 + (gt >> 2)] = (gt < 4) ? s : log_sigmoid_f(s); }
    __syncthreads();
}
__device__ __forceinline__ void mA_unit(Frame& F, KArgs a, int l, int u) {
    unsigned char* ws = a->ws; const int tid = F.tid, lane = (F.tid & 63), w = F.wave, g = lane >> 4, li = lane & 15; const int h = u & 3, rb = u >> 2;
    LAS bf16* XC = (LAS bf16*)F.lds; LAS bf16* MH = (LAS bf16*)(F.lds + 36864); LAS bf16* QT = MH; LAS bf16* VW = (LAS bf16*)F.lds; LAS bf16* KT = (LAS bf16*)(F.lds + 71680); LAS bf16* VX = (LAS bf16*)(F.lds + 106496);
    LAS float* vli = (LAS float*)(F.lds + 143360); LAS float* vlf = vli + 128; LAS float* vwk = vli + 256;
    const bf16* MX = slotp(ws, S_MX); const int r0 = rb * 128, pos0 = r0 & (SEQ - 1);
    { const int ch = tid & 15, rg = tid >> 4, t0 = 4 * rg; float xc[4][8], xm[4][8];
      conv_block(MX, a->in[14] + (size_t)l * 4 * 512, a->in[15] + (size_t)l * 512, r0, pos0, h * 128 + ch * 8, t0, xc, xm);
#pragma unroll
      for (int tt = 0; tt < 4; ++tt) { *(LAS v4u*)(XC + (t0 + tt) * TS + ch * 8) = pack8(xc[tt]); *(LAS v4u*)(MH + (t0 + tt) * TS + ch * 8) = pack8(xm[tt]); }
    }
    LBAR();
    if (w == 0) { const float* LIF = (const float*)(ws + WS_LIF);
        const v2u p0 = *(const v2u*)(LIF + ((size_t)(r0 + 2 * lane) * 4 + h) * 2), p1 = *(const v2u*)(LIF + ((size_t)(r0 + 2 * lane + 1) * 4 + h) * 2);
        const float l0 = __uint_as_float(p0.x), f0 = __uint_as_float(p0.y), l1 = __uint_as_float(p1.x), f1 = __uint_as_float(p1.y);
        float incl = f0 + f1;
#pragma unroll
        for (int o = 1; o < 64; o <<= 1) { const float t = __shfl_up(incl, o); if (lane >= o) incl += t; }
        const float b1 = incl, b0 = incl - f1, a0 = l0 - b0, a1 = l1 - b1; float am = fmaxf(a0, a1);
#pragma unroll
        for (int o = 1; o < 64; o <<= 1) am = fmaxf(am, __shfl_xor(am, o));
        const float blast = __shfl(incl, 63);
        vwk[2 * lane] = expf(a0 - am); vwk[2 * lane + 1] = expf(a1 - am);
        if (lane == 0) { float* CS = (float*)(ws + WS_CS); CS[2 * u] = blast; CS[2 * u + 1] = blast + am; } }
    { const int row = tid >> 2, q4 = tid & 3; unsigned z_ = 0u; asm volatile("" : "+v"(z_));
      if (q4 == 0) { *(LAS v4u*)(VX + row * 144 + 128) = (v4u){0x00003F80u | z_, z_, z_, z_}; *(LAS v4u*)(VX + row * 144 + 136) = (v4u){z_, z_, z_, z_}; } }
    const bf16* WQKV = (const bf16*)(ws + WS_WQKV);
    bf16x8 Afa[3][4];
#pragma unroll
    for (int mt = 0; mt < 3; ++mt)
#pragma unroll
        for (int ks = 0; ks < 4; ++ks) Afa[mt][ks] = *(const bf16x8*)(WQKV + ((size_t)(mt * 4 + h) * 128 + 16 * w + li) * 128 + 32 * ks + 8 * g);
#pragma unroll
    for (int pass = 0; pass < 3; ++pass) { const int mt = (pass == 0) ? 2 : pass - 1;
        bf16x8 Af[4];
#pragma unroll
        for (int ks = 0; ks < 4; ++ks) Af[ks] = Afa[mt][ks];
        const LAS bf16* src = (mt == 2) ? MH : XC; const float sc = (mt == 1) ? 0.08838834764831845f : 1.0f;
#pragma unroll 2
        for (int tb = 0; tb < 8; ++tb) { f32x4 acc = {0.f, 0.f, 0.f, 0.f};
#pragma unroll
            for (int ks = 0; ks < 4; ++ks) { const bf16x8 B = *(const LAS bf16x8*)(src + (16 * tb + li) * TS + 32 * ks + 8 * g); acc = mfma16(Af[ks], B, acc); }
            v2u o; o.x = pkbf(acc[0] * sc, acc[1] * sc); o.y = pkbf(acc[2] * sc, acc[3] * sc);
            if (mt == 0) *(LAS v2u*)(QT + (16 * tb + li) * TS + 16 * w + 4 * g) = o;
            if (mt == 1) *(LAS v2u*)(KT + (16 * tb + li) * TS + 16 * w + 4 * g) = o;
            if (mt == 2) *(LAS v2u*)(VX + (16 * tb + li) * 144 + 16 * w + 4 * g) = o; }
        if (pass == 0) LBAR();
    }
    LBAR();
#pragma unroll
    for (int i = 0; i < 4; ++i) { const int idx = tid + 512 * i, row = idx >> 4, ch = idx & 15; const size_t go = (size_t)(r0 + row) * 512 + h * 128 + ch * 8;
        *(v4u*)(slotp(ws, S_MQ) + go) = *(const LAS v4u*)(QT + row * TS + ch * 8); *(v4u*)(slotp(ws, S_MK) + go) = *(const LAS v4u*)(KT + row * TS + ch * 8); *(v4u*)(slotp(ws, S_MV) + go) = *(const LAS v4u*)(VX + row * 144 + ch * 8); }
    { const int s = tid >> 2, q4 = tid & 3; const float wk = vwk[s];
#pragma unroll
      for (int k = 0; k < 9; ++k) { const v2u xw = *(const LAS v2u*)(VX + s * 144 + q4 * 36 + 4 * k); v2u o; o.x = pkbf(bflo(xw.x) * wk, bfhi(xw.x) * wk); o.y = pkbf(bflo(xw.y) * wk, bfhi(xw.y) * wk); *(LAS v2u*)(VW + s * 144 + q4 * 36 + 4 * k) = o; } }
    LBAR();
    { f32x4 acc[9];
#pragma unroll
      for (int nt = 0; nt < 9; ++nt) acc[nt] = (f32x4){0.f, 0.f, 0.f, 0.f};
#pragma unroll
      for (int ks = 0; ks < 4; ++ks) { const bf16x8 Bk = tr2(KT, 32 * ks + 8 * g, 16 * w, TS, lane);
#pragma unroll
          for (int nt = 0; nt < 9; ++nt) acc[nt] = mfma16(tr2(VW, 32 * ks + 8 * g, 16 * nt, 144, lane), Bk, acc[nt]); }
      bf16* KV = kv_ptr(ws, u); float* NV = (float*)(ws + WS_NV) + (size_t)u * 128;
#pragma unroll
      for (int nt = 0; nt < 8; ++nt) { v2u o; o.x = pkbf(acc[nt][0], acc[nt][1]); o.y = pkbf(acc[nt][2], acc[nt][3]); *(v2u*)(KV + (size_t)(16 * w + li) * 128 + 16 * nt + 4 * g) = o; }
      if (g == 0) NV[16 * w + li] = acc[8][0];
    }
    LBAR();
}

__device__ __forceinline__ void job_scan(Frame& F, KArgs a) {
    unsigned char* ws = a->ws; const float* CS = (const float*)(ws + WS_CS); float* MP = (float*)(ws + WS_MP); const float* NV = (const float*)(ws + WS_NV); float* NP = (float*)(ws + WS_NP); bf16* CP = slotp(ws, S_CP);
    const int rank = F.vcu & 31, b = F.vcu >> 5, h = rank >> 3, e = (rank & 7) * (NWAVES * 64) + F.tid; const bool hasn = e < 128;
    v2u cs[16], kw[16]; float nv[16];
#pragma unroll
    for (int c = 0; c < 16; ++c) { const int u = (b * 16 + c) * 4 + h; cs[c] = *(const v2u*)(CS + 2 * u); kw[c] = *(const v2u*)(kv_ptr(ws, u) + 4 * e); nv[c] = NV[(size_t)u * 128 + (hasn ? e : 0)]; }
    asm volatile("" ::: "memory");
    float z_ = 0.f; asm volatile("" : "+v"(z_));
    float m = 0.f; f32x4 C = {z_, z_, z_, z_}; float nn = z_;
#pragma unroll
    for (int c = 0; c < 16; ++c) { const int u = (b * 16 + c) * 4 + h; const float blast = __uint_as_float(cs[c].x), mloc = __uint_as_float(cs[c].y);
        const float mnew = fmaxf(blast + m, mloc), dec = __expf(blast + m - mnew), sc = __expf(mloc - mnew);
        { v2u o; o.x = pkbf(C[0], C[1]); o.y = pkbf(C[2], C[3]); *(v2u*)(CP + (size_t)u * 16384 + 4 * e) = o; const v2u w_ = kw[c]; const f32x4 kv = {bflo(w_.x), bfhi(w_.x), bflo(w_.y), bfhi(w_.y)}; C = C * dec + kv * sc; if (e == 0) MP[u] = m; }
        if (hasn) { NP[(size_t)u * 128 + e] = nn; nn = nn * dec + nv[c] * sc; }
        m = mnew; }
}

__device__ __forceinline__ void mC_unit(Frame& F, KArgs a, int l, int u, int out_slot) {
    unsigned char* ws = a->ws; const int tid = F.tid, lane = (F.tid & 63), w = F.wave, g = lane >> 4, li = lane & 15; const int h = u & 3, rb = u >> 2;
    LAS bf16* QS = (LAS bf16*)F.lds; LAS bf16* KT = (LAS bf16*)(F.lds + 34816); LAS bf16* VX = (LAS bf16*)(F.lds + 69632); LAS bf16* CL = (LAS bf16*)(F.lds + 106496); LAS bf16* HT = KT;
    LAS float* va = (LAS float*)(F.lds + 143360); LAS float* vM = va + 128; LAS float* vwi = va + 256; LAS float* vemt = va + 384;
    const bf16* MQ = slotp(ws, S_MQ); const bf16* MK = slotp(ws, S_MK); bf16* MV = slotp(ws, S_MV); const bf16* CP = slotp(ws, S_CP) + (size_t)u * 16384; const float* NP = (const float*)(ws + WS_NP) + (size_t)u * 128;
    const size_t row0 = (size_t)rb * 128;
    { v4u tq[4], tk[4], tv[4], tc[4];
#pragma unroll
      for (int i = 0; i < 4; ++i) { const int idx = tid + 512 * i, row = idx >> 4, ch = idx & 15;
          tq[i] = *(const v4u*)(MQ + (row0 + row) * 512 + h * 128 + ch * 8); tk[i] = *(const v4u*)(MK + (row0 + row) * 512 + h * 128 + ch * 8);
          tv[i] = *(const v4u*)(MV + (row0 + row) * 512 + h * 128 + ch * 8); tc[i] = *(const v4u*)(CP + row * 128 + ch * 8); }
      __builtin_amdgcn_sched_barrier(0);
#pragma unroll
      for (int i = 0; i < 4; ++i) { const int idx = tid + 512 * i, row = idx >> 4, ch = idx & 15;
          *(LAS v4u*)(QS + row * TS + ch * 8) = tq[i]; *(LAS v4u*)(KT + row * TS + ch * 8) = tk[i]; *(LAS v4u*)(VX + row * 144 + ch * 8) = tv[i]; *(LAS v4u*)(CL + row * 144 + ch * 8) = tc[i]; } }
    { const int row = tid >> 2, q4 = tid & 3; unsigned z_ = 0u; asm volatile("" : "+v"(z_));
      if (q4 == 0) { *(LAS v4u*)(VX + row * 144 + 128) = (v4u){0x00003F80u | z_, z_, z_, z_}; *(LAS v4u*)(VX + row * 144 + 136) = (v4u){z_, z_, z_, z_}; }
      if (q4 == 1) { *(LAS v4u*)(CL + row * 144 + 128) = (v4u){pkbf(NP[row], 0.f), z_, z_, z_}; *(LAS v4u*)(CL + row * 144 + 136) = (v4u){z_, z_, z_, z_}; } }
    if (w == 0) { const float* LIF = (const float*)(ws + WS_LIF); const float mprev = ((const float*)(ws + WS_MP))[u];
        const v2u p0 = *(const v2u*)(LIF + ((row0 + 2 * lane) * 4 + h) * 2), p1 = *(const v2u*)(LIF + ((row0 + 2 * lane + 1) * 4 + h) * 2);
        const float l0 = __uint_as_float(p0.x), f0 = __uint_as_float(p0.y), l1 = __uint_as_float(p1.x), f1 = __uint_as_float(p1.y);
        float incl = f0 + f1;
#pragma unroll
        for (int o = 1; o < 64; o <<= 1) { const float t = __shfl_up(incl, o); if (lane >= o) incl += t; }
        const float b1 = incl, b0 = incl - f1, a0 = l0 - b0, a1 = l1 - b1; float inc = fmaxf(a0, a1);
#pragma unroll
        for (int o = 1; o < 64; o <<= 1) { const float t = __shfl_up(inc, o); if (lane >= o) inc = fmaxf(inc, t); }
        float exc = __shfl_up(inc, 1); if (lane == 0) exc = -INFINITY;
        const float M0 = fmaxf(mprev, fmaxf(exc, a0)), M1 = fmaxf(mprev, inc);
        va[2 * lane] = a0; va[2 * lane + 1] = a1; vM[2 * lane] = M0; vM[2 * lane + 1] = M1;
        vwi[2 * lane] = expf(mprev - M0); vwi[2 * lane + 1] = expf(mprev - M1); vemt[2 * lane] = expf(-(b0 + M0)); vemt[2 * lane + 1] = expf(-(b1 + M1)); }
    LBAR();
    bf16x8 qf[4];
#pragma unroll
    for (int ks = 0; ks < 4; ++ks) qf[ks] = *(const LAS bf16x8*)(QS + (16 * w + li) * TS + 32 * ks + 8 * g);
    LBAR();
    const int t = 16 * w + li; const float Mt = vM[t]; const int nst = (w | 1) + 1;
#pragma unroll 1
    for (int st = 0; st < nst; ++st) { f32x4 acc = {0.f, 0.f, 0.f, 0.f};
#pragma unroll
        for (int ks = 0; ks < 4; ++ks) { const bf16x8 A = *(const LAS bf16x8*)(KT + (16 * st + li) * TS + 32 * ks + 8 * g); acc = mfma16(A, qf[ks], acc); }
        const f32x4 a4 = *(const LAS f32x4*)(va + 16 * st + 4 * g); float sw[4];
#pragma unroll
        for (int r = 0; r < 4; ++r) { const int s = 16 * st + 4 * g + r; const float e = __expf(fminf(a4[r] - Mt, 0.f)); sw[r] = (s <= t) ? acc[r] * e : 0.f; }
        v2u o; o.x = pkbf(sw[0], sw[1]); o.y = pkbf(sw[2], sw[3]); *(LAS v2u*)(QS + t * TS + 16 * st + 4 * g) = o; }
    LBAR();
    { f32x4 accn[9], accq[9];
#pragma unroll
      for (int nt = 0; nt < 9; ++nt) { accn[nt] = (f32x4){0.f, 0.f, 0.f, 0.f}; accq[nt] = accn[nt]; }
      const int nks = (w >> 1) + 1;
#pragma unroll 1
      for (int ks = 0; ks < nks; ++ks) { const bf16x8 Bs = *(const LAS bf16x8*)(QS + t * TS + 32 * ks + 8 * g);
#pragma unroll
          for (int nt = 0; nt < 9; ++nt) accn[nt] = mfma16(tr2(VX, 32 * ks + 8 * g, 16 * nt, 144, lane), Bs, accn[nt]); }
#pragma unroll
      for (int ks = 0; ks < 4; ++ks)
#pragma unroll
          for (int nt = 0; nt < 9; ++nt) accq[nt] = mfma16(tr2(CL, 32 * ks + 8 * g, 16 * nt, 144, lane), qf[ks], accq[nt]);
      const float wi = vwi[t], em = vemt[t];
      const float den = wi * accq[8][0] + accn[8][0]; const float dn = __shfl(den, li); const float inv = 1.0f / fmaxf(fabsf(dn), em);
#pragma unroll
      for (int nt = 0; nt < 8; ++nt) { const f32x4 hv = (accq[nt] * wi + accn[nt]) * inv; v2u o; o.x = pkbf(hv[0], hv[1]); o.y = pkbf(hv[2], hv[3]); *(LAS v2u*)(HT + t * TS + 16 * nt + 4 * g) = o; }
    }
    LBAR();
    { const int ch = tid & 15, rg = tid >> 4, t0 = 4 * rg, c0 = h * 128 + ch * 8; const int r0 = rb * 128, pos0 = r0 & (SEQ - 1);
      float xc[4][8], xm[4][8]; conv_block(slotp(ws, S_MX), a->in[14] + (size_t)l * 4 * 512, a->in[15] + (size_t)l * 512, r0, pos0, c0, t0, xc, xm);
      const float* nw = a->in[21] + (size_t)l * 512 + c0; const float* sk = a->in[22] + (size_t)l * 512 + c0; const bf16* MZ = slotp(ws, S_MZ);
      float nn[8], ss[8];
#pragma unroll
      for (int i = 0; i < 8; ++i) { nn[i] = nw[i]; ss[i] = sk[i]; }
#pragma unroll
      for (int tt = 0; tt < 4; ++tt) { float hm[8], z[8]; unpack8(*(const LAS v4u*)(HT + (t0 + tt) * TS + ch * 8), hm); unpack8(*(const v4u*)(MZ + (size_t)(r0 + t0 + tt) * 512 + c0), z);
          float s = 0.f;
#pragma unroll
          for (int i = 0; i < 8; ++i) s += hm[i];
          s += __shfl_xor(s, 1); s += __shfl_xor(s, 2); s += __shfl_xor(s, 4); s += __shfl_xor(s, 8);
          const float mu = s * (1.0f / 128.0f); float q = 0.f;
#pragma unroll
          for (int i = 0; i < 8; ++i) { hm[i] -= mu; q += hm[i] * hm[i]; }
          q += __shfl_xor(q, 1); q += __shfl_xor(q, 2); q += __shfl_xor(q, 4); q += __shfl_xor(q, 8);
          const float rstd = 1.0f / sqrtf(q * (1.0f / 128.0f) + 1e-5f); float o[8];
#pragma unroll
          for (int i = 0; i < 8; ++i) o[i] = (hm[i] * rstd * nn[i] + ss[i] * xc[tt][i]) * silu_f(z[i]);
          *(v4u*)(slotp(ws, out_slot) + (size_t)(r0 + t0 + tt) * 512 + c0) = pack8(o); }
    }
    LBAR();
}

__device__ __forceinline__ void job_final_norm(Frame& F, KArgs a) {
    const int gw = F.vcu * NWAVES + F.wave, NGW = F.G * NWAVES, lane = (F.tid & 63); const float* RS = (const float*)(a->ws + WS_RS); const bf16* XB = (const bf16*)(a->ws + WS_XB); const f32x4* fw = (const f32x4*)a->in[31] + 2 * lane;
    f32x4 wv[4];
#pragma unroll
    for (int j = 0; j < 2; ++j) { wv[2 * j] = fw[128 * j]; wv[2 * j + 1] = fw[128 * j + 1]; }
    for (int m = gw; m < M; m += NGW) { const float rs = row_rstd(RS, m); const v4u* xr = (const v4u*)(XB + (size_t)m * D) + lane; f32x4* orow = (f32x4*)(a->out + (size_t)m * D) + 2 * lane;
#pragma unroll
        for (int j = 0; j < 2; ++j) { float x[8]; unpack8(xr[64 * j], x);
            orow[128 * j] = (f32x4){x[0], x[1], x[2], x[3]} * rs * wv[2 * j]; orow[128 * j + 1] = (f32x4){x[4], x[5], x[6], x[7]} * rs * wv[2 * j + 1]; } }
}
#define XB_TMO      128
#define XB_XCNT(j)  (256  + 64 * (j))
#define XB_XSUB(j)  (1280 + 64 * (j))
#define XB_XGEN(j)  (2304 + 64 * (j))
#define XB_TOP      3328
#define XB_TOPGEN   3392
#define XCD_BAR_WORDS 3456
#define XB_PSUB(j)  (4096 + 64 * (j))
#define XB_PGEN(j)  (8192 + 64 * (j))
#define XB_XPAN(j)  (12288 + 64 * (j))
#define XB_SPIN_CAP (1u << 18)

__device__ __forceinline__ unsigned xb_ld(unsigned* p)              { return __hip_atomic_load(p, __ATOMIC_RELAXED, __HIP_MEMORY_SCOPE_AGENT); }
__device__ __forceinline__ unsigned xb_add(unsigned* p, unsigned v) { return __hip_atomic_fetch_add(p, v, __ATOMIC_RELAXED, __HIP_MEMORY_SCOPE_AGENT); }
__device__ __forceinline__ unsigned xb_xcc_id() { return (unsigned)__builtin_amdgcn_s_getreg((3 << 11) | 20) & 0xFu; }
#define XB_SPIN(cond, bar) do { unsigned _sp = 0; while (cond) { __builtin_amdgcn_s_sleep(1); \
    if ((++_sp & 255u) == 0u) { if (xb_ld(&(bar)[XB_TMO])) break; if (_sp > XB_SPIN_CAP) { atomicAdd(&(bar)[XB_TMO], 1u); break; } } } } while (0)

struct XcdBarrier {
    unsigned* bar; unsigned x;
    volatile LAS unsigned* st;
};

__device__ __forceinline__ XcdBarrier xcd_barrier_post(unsigned* bar, volatile LAS unsigned* st) {
    XcdBarrier b; b.bar = bar; b.x = xb_xcc_id(); b.st = st;
    if (threadIdx.x == 0) st[2] = xb_add(&bar[XB_XCNT(b.x)], 1u);
    return b;
}
__device__ __forceinline__ void xcd_barrier_complete(unsigned* bar, unsigned x, unsigned& nloc, unsigned& nx, unsigned& regular) {
    const unsigned G = gridDim.x * gridDim.y * gridDim.z;
    unsigned sum, cnt, mine, reg, sp = 0u;
    for (;;) {
        sum = 0u; cnt = 0u; mine = 0u; reg = 1u;
#pragma unroll
        for (unsigned j = 0; j < 16; ++j) { const unsigned c = xb_ld(&bar[XB_XCNT(j)]); sum += c; cnt += (c > 0u) ? 1u : 0u; mine = (j == x) ? c : mine; reg = (c == (j < 8u ? G / 8u : 0u)) ? reg : 0u; }
        if (sum == G) break;
        __builtin_amdgcn_s_sleep(1);
        if ((++sp & 255u) == 0u) { if (xb_ld(&bar[XB_TMO])) break; if (sp > XB_SPIN_CAP) { atomicAdd(&bar[XB_TMO], 1u); break; } }
    }
    nloc = mine > 0u ? mine : 1u; nx = cnt > 0u ? cnt : 1u; regular = (sum == G && (G & 7u) == 0u) ? reg : 0u;
}

__device__ __forceinline__ void xcd_barrier(const XcdBarrier& b, int local = 0) {
    asm volatile("s_waitcnt vmcnt(0)" ::: "memory");
    __syncthreads();
    if (threadIdx.x == 0) {
        unsigned* bar = b.bar;
        __builtin_amdgcn_s_waitcnt(0);
        unsigned nloc = b.st[0], nx = b.st[1];
        if (nloc == 0u) { unsigned rg; xcd_barrier_complete(bar, b.x, nloc, nx, rg); b.st[0] = nloc; b.st[1] = nx; b.st[3] = rg; }
        if (local == 2 && nloc != 0u && b.st[3] != 0u) {
            const unsigned j = b.x * 8u + (b.st[2] & 7u);
            __hip_atomic_fetch_add(&bar[XB_XPAN(b.x)], 1u, __ATOMIC_RELAXED, __HIP_MEMORY_SCOPE_AGENT);
            const unsigned old = xb_add(&bar[XB_PSUB(j)], 1u);
            const unsigned gen = old >> 2;
            if ((old & 3u) == 3u) { __builtin_amdgcn_fence(__ATOMIC_ACQUIRE, "agent"); xb_add(&bar[XB_PGEN(j)], 1u); asm volatile("s_waitcnt vmcnt(0)" ::: "memory"); }
            else { XB_SPIN(xb_ld(&bar[XB_PGEN(j)]) == gen, bar); __builtin_amdgcn_fence(__ATOMIC_ACQUIRE, "agent"); asm volatile("s_waitcnt vmcnt(0)" ::: "memory"); }
        } else {
        const unsigned old = xb_add(&bar[XB_XSUB(b.x)], 1u);
        const unsigned gen = old / nloc;
        const bool loc = (local != 0) && b.st[3] != 0u;
        if (old + 1u == (gen + 1u) * nloc) {
          if (!loc) {
            __builtin_amdgcn_fence(__ATOMIC_RELEASE, "agent");
            asm volatile("s_waitcnt vmcnt(0)" ::: "memory");
            const unsigned og = xb_add(&bar[XB_TOP], 1u);
            const unsigned tg = og / nx;
            if (og + 1u == (tg + 1u) * nx) xb_add(&bar[XB_TOPGEN], 1u);
            else XB_SPIN(xb_ld(&bar[XB_TOPGEN]) == tg, bar);
          }
            __builtin_amdgcn_fence(__ATOMIC_ACQUIRE, "agent");
            xb_add(&bar[XB_XGEN(b.x)], 1u);
            asm volatile("s_waitcnt vmcnt(0)" ::: "memory");
        } else {
            XB_SPIN(xb_ld(&bar[XB_XGEN(b.x)]) == gen, bar);
            __builtin_amdgcn_fence(__ATOMIC_ACQUIRE, "agent");
            asm volatile("s_waitcnt vmcnt(0)" ::: "memory");
        }
        }
    }
    __syncthreads();
}

__device__ __forceinline__ void xcc_progress_wait(const XcdBarrier& b, unsigned gen) {
    if (threadIdx.x == 0 && b.st[3] != 0u) {
#pragma unroll 1
        for (unsigned j = 0; j < 8; ++j) XB_SPIN(xb_ld(&b.bar[XB_XPAN(j)]) < 32u * gen, b.bar);
    }
    __syncthreads();
}

struct EpiResidFinal {
    static constexpr bool PERM = true, AFTER_DRAIN = false, SHADOW = false, KEEP_ACC = false;
    const bf16* base; float* RS; float* out; const float* fw; float scale; XcdBarrier bar;
    __device__ __forceinline__ void pre_store(int) const {}
    __device__ __forceinline__ void operator()(const pg8::f32x4 (&acc_)[2][2][4][2], const pg8::Unit& u, int wr, int wc, int fr, int fq) const {
        pg8::f32x4 (&acc)[2][2][4][2] = const_cast<pg8::f32x4 (&)[2][2][4][2]>(acc_);
        const int row0 = u.pm * pg8::BM + wr * 64 + fr; const int col0 = u.pn * pg8::BM + wc * 32 + 8 * fq;
        v4u rbw[4][2];
#pragma unroll
        for (int i = 0; i < 4; ++i)
#pragma unroll
            for (int bj = 0; bj < 2; ++bj) rbw[i][bj] = *(const v4u*)(base + (size_t)(row0 + i * 16) * 1024 + col0 + bj * pg8::HALF);
#pragma unroll
        for (int i = 0; i < 8; ++i) { const int ai = i >> 2, m = i & 3; const int row = row0 + ai * pg8::HALF + m * 16; float s = 0.f;
            v4u cbw[2];
#pragma unroll
            for (int bj = 0; bj < 2; ++bj) cbw[bj] = rbw[m][bj];
            if (i < 4) { const int rown = row0 + pg8::HALF + m * 16;
#pragma unroll
                for (int bj = 0; bj < 2; ++bj) rbw[m][bj] = *(const v4u*)(base + (size_t)rown * 1024 + col0 + bj * pg8::HALF); }
#pragma unroll
            for (int bj = 0; bj < 2; ++bj) { const v4u bw = cbw[bj];
                pg8::f32x4 x0 = acc[ai][bj][m][0] * scale, x1 = acc[ai][bj][m][1] * scale;
                x0[0] += bflo(bw.x); x0[1] += bfhi(bw.x); x0[2] += bflo(bw.y); x0[3] += bfhi(bw.y); x1[0] += bflo(bw.z); x1[1] += bfhi(bw.z); x1[2] += bflo(bw.w); x1[3] += bfhi(bw.w);
                acc[ai][bj][m][0] = x0; acc[ai][bj][m][1] = x1;
                s += ((x0[0] * x0[0] + x0[1] * x0[1]) + (x0[2] * x0[2] + x0[3] * x0[3])) + ((x1[0] * x1[0] + x1[1] * x1[1]) + (x1[2] * x1[2] + x1[3] * x1[3])); }
            s += __shfl_xor(s, 16); s += __shfl_xor(s, 32);
            if (fq == 0) RS[(size_t)row * 16 + u.pn * 4 + wc] = s; }
        xcd_barrier(bar, 2);
        float rs8[8]; pg8::rows_rstd8(RS, row0, fq, rs8);
        pg8::f32x4 wv[2][2];
#pragma unroll
        for (int bj = 0; bj < 2; ++bj) { wv[bj][0] = *(const pg8::f32x4*)(fw + col0 + bj * pg8::HALF); wv[bj][1] = *(const pg8::f32x4*)(fw + col0 + bj * pg8::HALF + 4); }
#pragma unroll
        for (int i = 0; i < 8; ++i) { const int ai = i >> 2, m = i & 3; const int row = row0 + ai * pg8::HALF + m * 16; const float rs = rs8[i];
#pragma unroll
            for (int bj = 0; bj < 2; ++bj) { float* o = out + (size_t)row * 1024 + col0 + bj * pg8::HALF;
                *(pg8::f32x4*)o = acc[ai][bj][m][0] * rs * wv[bj][0]; *(pg8::f32x4*)(o + 4) = acc[ai][bj][m][1] * rs * wv[bj][1]; } }
    }
};

#ifndef STAGGER_TICKS
#define STAGGER_TICKS 1200ull
#endif
#ifndef PROBE_MASK
#define PROBE_MASK 0
#endif
constexpr int NSUB = 12, N_PHASES = NSUB * DEPTH;
__device__ __forceinline__ void run_phase(Frame& F, KArgs a, int p, bool dry, const XcdBarrier& bar) {
    unsigned char* ws = a->ws; const int l = p / NSUB, sub = p % NSUB;
    bf16* XB = (bf16*)(ws + WS_XB); float* RS = (float*)(ws + WS_RS);
    unsigned* const xsub = (((volatile LAS unsigned*)(F.lds + XB_LDS_OFF))[3] != 0u) ? (unsigned*)(ws + WS_CTL) + XB_XSUB(0) : nullptr;
    unsigned* const xpan = (xsub != nullptr) ? (unsigned*)(ws + WS_CTL) + XB_XPAN(0) : nullptr;
    const unsigned seam0 = (l == 0) ? 1u : (unsigned)NSUB;
#define WAR_EARLY(base_, need_) (((base_) != nullptr && (F.tid & 63) < 8) ? __hip_atomic_load((base_) + 64 * (F.tid & 63), __ATOMIC_RELAXED, __HIP_MEMORY_SCOPE_AGENT) : (need_))
#define WAR_PTR(base_, pv_, need_) (((base_) != nullptr && !__all((pv_) >= (need_))) ? (base_) : nullptr)
    switch (sub) {
    case 0: if (l == 0) phase_prep(F, a, 0, (F.G == 256) ? (1 | 2 | 8) : (1 | 16 | 4 | 8), F.vcu * NWAVES + F.wave, F.G * NWAVES); break;
    case 1: case 10: {
        pg8::Gemm g{XB, (const bf16*)(ws + (sub == 1 ? WS_W1 : WS_W3)), 0, 0, D};
        pg8::StaticOrder S; S.init(M, 2 * FF, F.G, F.vbx);
        const unsigned need = 32u * (4u * l + 3u); const unsigned pv = (sub == 10) ? WAR_EARLY(xpan, need) : need;
        pg8::lds_fp tab = (pg8::lds_fp)(F.lds + RING_BYTES); pg8::fill_rstd_table(S, RS, tab, F.tid);
        pg8::EpiSwiGLU E{slotp(ws, 0), tab, (sub == 10) ? WAR_PTR(xpan, pv, need) : nullptr, need};
        pg8::gemm_phase<pg8::EpiSwiGLU, pg8::StaticOrder, true, true>(F.lds, g, S, E);
        if (F.G == 256 && F.vbx >= 128 && !dry) { const int gw2 = (F.vbx - 128) * NWAVES + F.wave;
            if (sub == 1) phase_prep(F, a, l, (l == 0) ? (4 | 16) : (2 | 16), gw2, 128 * NWAVES); else if (l + 1 < DEPTH) { xcc_progress_wait(bar, (unsigned)(4 * l + 3));        phase_prep(F, a, l + 1, 1 | 4, gw2, 128 * NWAVES); } }
        else if (F.G != 256 && !dry) { const int gw2 = F.vcu * NWAVES + F.wave; if (sub == 1) phase_prep(F, a, l, 2, gw2, F.G * NWAVES); else if (l + 1 < DEPTH) phase_prep(F, a, l + 1, 1 | 16 | 4, gw2, F.G * NWAVES); }
    } break;
    case 2: case 11: case 9: {
        const bf16* A = (sub == 9) ? slotp(ws, S_MG) : slotp(ws, 0); const bf16* B = (const bf16*)(ws + (sub == 2 ? WS_W2 : (sub == 11 ? WS_W4 : WS_WO)));
        pg8::Gemm g{A, B, 0, 0, (sub == 9) ? D : FF};
        pg8::StaticOrder S; S.init(M, D, F.G, F.vbx);
        if (p == N_PHASES - 1 && !dry) {
            EpiResidFinal E{XB, RS, a->out, a->in[31], 0.5f, bar};
            pg8::gemm_phase<EpiResidFinal, pg8::StaticOrder, true, true>(F.lds, g, S, E);
        } else {
            pg8::EpiResid E{XB, dry ? slotp(ws, 6) : XB, dry ? (float*)slotp(ws, 10) : RS, (sub == 9) ? 1.0f : 0.5f};
            pg8::gemm_phase<pg8::EpiResid, pg8::StaticOrder, false, true>(F.lds, g, S, E);
        }
    } break;
    case 3: {
        if (!dry) job_ff(F, ws);
        pg8::Gemm g{XB, (const bf16*)(ws + WS_WIN), 0, 0, D};
        pg8::StaticOrder S; S.init(M, 4096, F.G, F.vbx);
        const unsigned need = 32u * (4u * l + 1u); const unsigned pv = WAR_EARLY(xpan, need);
        pg8::lds_fp tab = (pg8::lds_fp)(F.lds + RING_BYTES); pg8::fill_rstd_table(S, RS, tab, F.tid);
        pg8::EpiProj E{slotp(ws, 0), tab, C2, WAR_PTR(xpan, pv, need), need};
        pg8::gemm_phase<pg8::EpiProj, pg8::StaticOrder, true, true>(F.lds, g, S, E);
    } break;
    case 4: job_gates(F, a, l); phase_attn(F, a, l, dry); break;
    case 5: {
        if (!dry) job_diff_combine(F, a, l);
        for (int k = 0; k < 2; ++k) mA_unit(F, a, l, (F.vcu >> 5) * 64 + (F.vcu & 31) + 32 * k);
    } break;
    case 6: job_scan(F, a); break;
    case 7: {
        for (int k = 0; k < 2; ++k) mC_unit(F, a, l, (F.vcu >> 5) * 64 + (F.vcu & 31) + 32 * k, dry ? 7 : S_MV);
    } break;
    case 8: {
        pg8::BranchOrder S; S.init(M, D, F.G, F.vbx);
        { pg8::Gemm g{XB, (const bf16*)(ws + WS_WIN) + (size_t)4096 * D, 0, (long)D * D, D};
          pg8::lds_fp tab = (pg8::lds_fp)(F.lds + RING_BYTES); pg8::lds_fp gbl = tab + 7 * 256;
          for (int i = F.tid; i < 3 * D; i += NWAVES * 64) gbl[i] = a->in[7][(size_t)l * 3 * D + i];
          const unsigned need = 32u * ((l == 0) ? 7u : 14u); const unsigned pv = WAR_EARLY(xsub, need);
          pg8::fill_rstd_table(S, RS, tab, F.tid);
          pg8::EpiGate E{WAR_PTR(xsub, pv, need), need, slotp(ws, S_G0), tab, gbl};
          pg8::gemm_phase<pg8::EpiGate, pg8::BranchOrder, true, true>(F.lds, g, S, E); }
        { const bf16* WBR = (const bf16*)(ws + WS_WBR);
          pg8::Gemm g{slotp(ws, S_DQ), WBR, (long)SLOT_ELEMS, (long)D * 512, 512};
          pg8::EpiBranch E{slotp(ws, S_G0), slotp(ws, S_MG)};
          pg8::gemm_phase<pg8::EpiBranch, pg8::BranchOrder, true, true>(F.lds, g, S, E); }
    } break;
    default: job_final_norm(F, a); break;
    }
#undef WAR_EARLY
#undef WAR_PTR
}

__global__ void __launch_bounds__(NWAVES * 64, 2) mega_fwd(Args a) {
    extern __shared__ __attribute__((aligned(16))) unsigned char lds[];
    Frame F;
    F.lds = (LAS unsigned char*)lds; F.ldsg = (char*)lds;
    F.tid = threadIdx.x; F.wave = __builtin_amdgcn_readfirstlane(F.tid >> 6);
    F.G = gridDim.x; { const int bx = blockIdx.x; F.vbx = bx; F.vcu = (F.G % 8 == 0) ? (bx % 8) * (F.G / 8) + bx / 8 : bx; }
    const int ph_lo = a.ph_lo, ph_hi = a.ph_hi;
    volatile LAS unsigned* bst = (volatile LAS unsigned*)(F.lds + XB_LDS_OFF);
    if (threadIdx.x < 4) bst[threadIdx.x] = 0u;
    __syncthreads();
    XcdBarrier bar = xcd_barrier_post((unsigned*)(a.ws + WS_CTL), bst);
    int p = ph_lo, rep = 0, nsync = 0;
    while (p < ph_hi) {
        KArgs ka = (KArgs)__builtin_amdgcn_kernarg_segment_ptr(); asm volatile("" : "+s"(ka));
        { int t_ = threadIdx.x; asm volatile("" : "+v"(t_)); F.tid = t_; F.wave = __builtin_amdgcn_readfirstlane(t_ >> 6); }
        if (p == NSUB) { ++p; continue; }
        const int sub_ = p % NSUB; const int reps = ((PROBE_MASK >> sub_) & 1) ? 2 : 1;
        run_phase(F, ka, p, rep + 1 < reps, bar);
        if (++rep == reps) { rep = 0; ++p; }
#if MK_COOP
        if (p < ph_hi) { if (nsync++ == 0) cg::this_grid().sync(); else xcd_barrier(bar); }
#else
        if (p < ph_hi) { ++nsync; const int sd = (p - 1) % NSUB; xcd_barrier(bar, (sd <= 1 || sd == NSUB - 1) ? 0 : ((sd == 2 || sd >= 8) ? 2 : 1));
            if (bst[3] != 0u) { const int x_ = __builtin_amdgcn_readfirstlane((int)bar.x), r_ = __builtin_amdgcn_readfirstlane((int)bst[2]); F.vbx = r_ * 8 + x_; F.vcu = x_ * (F.G / 8) + r_; } }
#endif
    }
}

extern "C" void kernel_launch(void* const* d_in, const int* in_sizes, int n_in, void* d_out, int out_size, void* d_ws, size_t ws_size, hipStream_t stream) {
    static int grid = 0;
    if (grid == 0) {
        if (n_in != 32 || in_sizes[0] != M * D || out_size != M * D || ws_size < WS_END) { fprintf(stderr, "kernel_launch: unexpected shapes (n_in %d, in0 %d, out %d, ws %zu < %zu); nothing launched\n", n_in, n_in > 0 ? in_sizes[0] : -1, out_size, ws_size, (size_t)WS_END); grid = -1; return; }
        int dev = 0, cus = 0, per_cu = 0;
        if (hipGetDevice(&dev) != hipSuccess || hipDeviceGetAttribute(&cus, hipDeviceAttributeMultiprocessorCount, dev) != hipSuccess) { grid = -1; return; }
        if (hipFuncSetAttribute((const void*)mega_fwd, hipFuncAttributeMaxDynamicSharedMemorySize, LDS_BYTES) != hipSuccess) { fprintf(stderr, "kernel_launch: hipFuncSetAttribute failed\n"); grid = -1; return; }
        if (hipOccupancyMaxActiveBlocksPerMultiprocessor(&per_cu, (const void*)mega_fwd, NWAVES * 64, LDS_BYTES) != hipSuccess || per_cu < 1) { fprintf(stderr, "kernel_launch: occupancy query says %d blocks per CU; nothing launched\n", per_cu); (void)hipGetLastError(); grid = -1; return; }
        if (cus != 256) { fprintf(stderr, "kernel_launch: built for a 256-CU device (one 256x256 tile per workgroup in the single-round phases); found %d CUs; nothing launched\n", cus); grid = -1; return; }
        grid = cus;
    }
    if (grid < 0) return;
    if (hipMemsetAsync((char*)d_ws + WS_CTL, 0, 65536, stream) != hipSuccess) { fprintf(stderr, "kernel_launch: hipMemsetAsync failed\n"); return; }
    Args a{};
    for (int i = 0; i < 32; ++i) a.in[i] = (const float*)d_in[i];
    a.out = (float*)d_out; a.ws = (unsigned char*)d_ws;
#if MK_N_LAUNCHES == 1 && MK_COOP
    a.ph_lo = 0; a.ph_hi = N_PHASES;
    void* args[] = {&a};
    hipError_t e = hipLaunchCooperativeKernel((const void*)mega_fwd, dim3(grid), dim3(NWAVES * 64), args, LDS_BYTES, stream);
    if (e != hipSuccess) fprintf(stderr, "kernel_launch: cooperative launch failed: %s (grid %d)\n", hipGetErrorString(e), grid);
#elif MK_N_LAUNCHES == 1
    a.ph_lo = 0; a.ph_hi = N_PHASES;
    hipLaunchKernelGGL(mega_fwd, dim3(grid), dim3(NWAVES * 64), LDS_BYTES, stream, a);
#else
    for (int p = 0; p < N_PHASES; ++p) { a.ph_lo = p; a.ph_hi = p + 1; hipLaunchKernelGGL(mega_fwd, dim3(grid), dim3(NWAVES * 64), LDS_BYTES, stream, a); }
#endif
}
```
